# Optimizing an MI355X kernel written in HIP

```python
import math
import jax, jax.numpy as jnp
from jax import lax
import numpy as np

D_MODEL = 2048
BATCH = 1
SEQ = 16384
DEPTH = 2

GRID_W = 64
CTX_LEN = 256
N_MOD = 6
EPS = 1e-6
HY_D = D_MODEL // 2
HY_HEADS = 8
HY_ORDER = 2
HY_EMB = 33
HY_FILTER_W = 64
HY_DECAY_TARGET = 1e-2
HY_FAST_PCT = 0.3
HY_SLOW_PCT = 1.5
HG_D = D_MODEL // 2
HG_EXPAND = 128
HG_HEADS = HG_D // HG_EXPAND
HG_CHUNK = 64
HG_Q0 = 3 * HY_D
HG_I0 = HG_Q0 + HG_D
IN_COLS = 3 * HY_D + 5 * HG_D
POOL_WINDOWS = (2, 4, 8, 16)
POOL_D = D_MODEL // len(POOL_WINDOWS)
D_FF = 5632

kernel_name = "hybrid_hyena_hgrn2_pool_convffn_dit"


def rmsnorm(x, g):
    xf = x.astype(jnp.float32)
    y = xf * lax.rsqrt(jnp.mean(xf * xf, axis=-1, keepdims=True) + EPS)
    return (y * g.astype(jnp.float32)).astype(x.dtype)


def head_rmsnorm(x, g, heads):
    B, L, C = x.shape
    xf = x.astype(jnp.float32).reshape(B, L, heads, C // heads)
    xf = xf * lax.rsqrt(jnp.mean(xf * xf, axis=-1, keepdims=True) + EPS)
    return (xf.reshape(B, L, C) * g).astype(x.dtype)


def adaln(cvec, w, b):
    return jnp.split((jax.nn.silu(cvec) @ w + b)[:, None, :], N_MOD, axis=-1)


def dwconv1d(x, w, b):
    L = x.shape[1]
    xp = jnp.pad(x, ((0, 0), (1, 1), (0, 0)))
    return xp[:, :L] * w[0] + xp[:, 1:L + 1] * w[1] + xp[:, 2:] * w[2] + b


def dwconv2d_grid(x, w, b):
    B, L, C = x.shape
    rows = L // GRID_W
    xg = jnp.pad(x.reshape(B, rows, GRID_W, C), ((0, 0), (1, 1), (1, 1), (0, 0)))
    y = b
    for di in range(3):
        for dj in range(3):
            y = y + xg[:, di:di + rows, dj:dj + GRID_W] * w[di, dj]
    return y.reshape(B, L, C)


def hyena_filters(L, w1, b1, w2, b2, w3, b3, freq, w4):
    t = jnp.linspace(0.0, 1.0, L, dtype=jnp.float32)[:, None]
    bands = (HY_EMB - 1) // 2
    f = jnp.linspace(1e-4, bands - 1, bands, dtype=jnp.float32)[None, :]
    w = (2.0 * math.pi / L) * jnp.arange(L, dtype=jnp.float32)[:, None]
    z = jnp.concatenate([t, jnp.cos(f * w), -jnp.sin(f * w)], axis=-1)
    h = jnp.sin(freq[0] * (z @ w1 + b1))
    h = jnp.sin(freq[1] * (h @ w2 + b2))
    h = jnp.sin(freq[2] * (h @ w3 + b3))
    h = (h @ w4).astype(jnp.float32).reshape(L, HY_ORDER, 2, HY_D)
    max_decay = math.log(HY_DECAY_TARGET) / HY_FAST_PCT
    min_decay = math.log(HY_DECAY_TARGET) / HY_SLOW_PCT
    deltas = jnp.abs(jnp.linspace(min_decay, max_decay, HY_D, dtype=jnp.float32))
    return h * jnp.exp(-t[:, :, None, None] * deltas)


def long_conv_bidir(u, h_fwd, h_bwd, skip):
    L = u.shape[1]
    kern = jnp.concatenate([h_fwd, jnp.zeros_like(h_fwd[:1]), h_bwd[:0:-1]], axis=0)
    uf = jnp.fft.rfft(u.astype(jnp.float32), n=2 * L, axis=1)
    kf = jnp.fft.rfft(kern.astype(jnp.float32), axis=0)
    y = jnp.fft.irfft(uf * kf[None], n=2 * L, axis=1)[:, :L]
    return (y + u * skip).astype(u.dtype)


def hyena_mixer(proj, conv_w, conv_b, filt, skip, norm_g):
    L = proj.shape[1]
    v, x1, x2 = jnp.split(dwconv1d(proj, conv_w, conv_b), 3, axis=-1)
    h = hyena_filters(L, *filt)
    z = v
    for n, gate in enumerate((x1, x2)):
        z = gate * long_conv_bidir(z, h[:, n, 0], h[:, n, 1], skip[n])
    return head_rmsnorm(z, norm_g, HY_HEADS)


def to_heads(a):
    B, L, _ = a.shape
    return a.reshape(B, L, HG_HEADS, HG_EXPAND).transpose(0, 2, 1, 3)


def hgrn_gates(f_logit, lb):
    f = lb + (1.0 - lb) * jax.nn.sigmoid(f_logit.astype(jnp.float32))
    return jnp.log(f), 1.0 - f


def gla_chunked(q, k, v, logf, s0):
    B, H, L, K = q.shape
    V = v.shape[-1]
    n = L // HG_CHUNK
    r = lambda a: a.reshape(B, H, n, HG_CHUNK, a.shape[-1])
    q, k, v, logf = r(q), r(k), r(v), r(logf)
    b = jnp.cumsum(logf, axis=3)
    b_last = b[:, :, :, -1:]
    q_in = q * jnp.exp(b)
    k_intra = k * jnp.exp(-b)
    k_state = k * jnp.exp(b_last - b)
    tri = jnp.tril(jnp.ones((HG_CHUNK, HG_CHUNK), dtype=bool))
    a = jnp.where(tri, jnp.einsum('bhntk,bhnsk->bhnts', q_in, k_intra), 0.0)
    o = jnp.einsum('bhnts,bhnsv->bhntv', a, v)
    ds = jnp.einsum('bhnsk,bhnsv->bhnkv', k_state, v)
    decay = jnp.exp(b_last[:, :, :, 0])

    def step(s, inp):
        d, u = inp
        return d[..., None] * s + u, s

    _, s_start = lax.scan(step, s0.astype(jnp.float32),
                          (jnp.moveaxis(decay, 2, 0), jnp.moveaxis(ds, 2, 0)))
    s_start = jnp.moveaxis(s_start, 0, 2)
    o = o + jnp.einsum('bhntk,bhnkv->bhntv', q_in, s_start)
    return o.reshape(B, H, L, V)


def gla_final_state(k, v, logf):
    b = jnp.cumsum(logf, axis=2)
    return jnp.einsum('bhsk,bhsv->bhkv', k * jnp.exp(b[:, :, -1:] - b), v)


def hgrn_context_states(i, f_fw, f_bw, lb):
    lbh = lb.reshape(HG_HEADS, 1, HG_EXPAND)
    vh = to_heads(i)
    logf_fw, k_fw = hgrn_gates(to_heads(f_fw), lbh)
    logf_bw, k_bw = hgrn_gates(to_heads(f_bw), lbh)
    flip = lambda a: jnp.flip(a, axis=2)
    return (gla_final_state(k_fw, vh, logf_fw),
            gla_final_state(flip(k_bw), flip(vh), flip(logf_bw)))


def hgrn_mixer(q, i, f_fw, f_bw, g, lb, norm_g, s0_fw, s0_bw):
    B, L, _ = q.shape
    lbh = lb.reshape(HG_HEADS, 1, HG_EXPAND)
    qh, vh = to_heads(jax.nn.silu(q)), to_heads(i)
    logf_fw, k_fw = hgrn_gates(to_heads(f_fw), lbh)
    logf_bw, k_bw = hgrn_gates(to_heads(f_bw), lbh)
    flip = lambda a: jnp.flip(a, axis=2)
    o_fw = gla_chunked(qh, k_fw, vh, logf_fw, s0_fw)
    o_bw = flip(gla_chunked(flip(qh), flip(k_bw), flip(vh), flip(logf_bw), s0_bw))
    o = (o_fw + o_bw).transpose(0, 2, 1, 3)
    o = o * lax.rsqrt(jnp.mean(o * o, axis=-1, keepdims=True) + EPS)
    return (o.reshape(B, L, HG_D) * norm_g * jax.nn.silu(g.astype(jnp.float32))).astype(q.dtype)


def pool_mixer(h, w, b, scale):
    B, L, D = h.shape
    hf = h.astype(jnp.float32)
    cs = jnp.pad(jnp.cumsum(hf, axis=1), ((0, 0), (1, 0), (0, 0)))
    t = jnp.arange(L)
    outs = []
    for gi, win in enumerate(POOL_WINDOWS):
        lo = jnp.clip(t - win // 2, 0, L)
        hi = jnp.clip(t + win // 2, 0, L)
        sl = slice(gi * POOL_D, (gi + 1) * POOL_D)
        csg = cs[:, :, sl]
        mean = (csg[:, hi] - csg[:, lo]) / (hi - lo).astype(jnp.float32)[:, None]
        outs.append(jnp.einsum('bld,de->ble', (mean - hf[:, :, sl]).astype(h.dtype), w[gi]) + b[gi])
    return jnp.concatenate(outs, axis=-1) * scale


def conv_ffn(h, w_up, conv_w, conv_b, w_down):
    a, u = jnp.split(h @ w_up, 2, axis=-1)
    a = dwconv2d_grid(a, conv_w, conv_b)
    return (jax.nn.gelu(a, approximate=False) * u) @ w_down


def setup_inputs(seed: int = 0) -> dict:
    key = jax.random.key(seed)
    keys = iter(jax.random.split(key, 64))
    n_even = (DEPTH + 1) // 2
    n_odd = DEPTH // 2

    def dense(shape, fan_in, s=1.0):
        return jax.random.normal(next(keys), shape, jnp.float32) * (s * fan_in ** -0.5)

    def gain(shape):
        return 1.0 + 0.02 * jax.random.normal(next(keys), shape, jnp.float32)

    def small(shape):
        return 0.01 * jax.random.normal(next(keys), shape, jnp.float32)

    return {
        "x": jax.random.normal(next(keys), (BATCH, SEQ, D_MODEL), jnp.float32),
        "c": jax.random.normal(next(keys), (BATCH, D_MODEL), jnp.float32),
        "ctx": jax.random.normal(next(keys), (BATCH, CTX_LEN, D_MODEL), jnp.float32),
        "c_ctx": jax.random.normal(next(keys), (D_MODEL,), jnp.float32),
        "norm_mix_g": gain((DEPTH, D_MODEL)),
        "norm_ffn_g": gain((DEPTH, D_MODEL)),
        "mod_w": dense((DEPTH, D_MODEL, N_MOD * D_MODEL), D_MODEL, 0.5),
        "mod_b": small((DEPTH, N_MOD * D_MODEL)),
        "in_w": dense((n_even, D_MODEL, IN_COLS), D_MODEL),
        "in_b": small((n_even, IN_COLS)),
        "hy_conv_w": dense((n_even, 3, 3 * HY_D), 3),
        "hy_conv_b": small((n_even, 3 * HY_D)),
        "hy_w1": dense((n_even, HY_EMB, HY_FILTER_W), HY_EMB),
        "hy_b1": small((n_even, HY_FILTER_W)),
        "hy_w2": dense((n_even, HY_FILTER_W, HY_FILTER_W), HY_FILTER_W),
        "hy_b2": small((n_even, HY_FILTER_W)),
        "hy_w3": dense((n_even, HY_FILTER_W, HY_FILTER_W), HY_FILTER_W),
        "hy_b3": small((n_even, HY_FILTER_W)),
        "hy_freq": gain((n_even, 3, HY_FILTER_W)),
        "hy_w4": dense((n_even, HY_FILTER_W, HY_ORDER * 2 * HY_D), HY_FILTER_W),
        "hy_skip": dense((n_even, HY_ORDER, HY_D), 1),
        "hy_norm_g": gain((n_even, HY_D)),
        "hg_lb_logits": gain((n_even + 1, HG_D)),
        "hg_norm_g": gain((n_even, HG_D)),
        "out_w": dense((n_even, D_MODEL, D_MODEL), D_MODEL),
        "pool_w": dense((n_odd, len(POOL_WINDOWS), POOL_D, POOL_D), POOL_D),
        "pool_b": small((n_odd, len(POOL_WINDOWS), POOL_D)),
        "pool_scale": gain((n_odd, D_MODEL)),
        "ffn_up_w": dense((DEPTH, D_MODEL, 2 * D_FF), D_MODEL),
        "ffn_conv_w": dense((DEPTH, 3, 3, D_FF), 9),
        "ffn_conv_b": small((DEPTH, D_FF)),
        "ffn_down_w": dense((DEPTH, D_FF, D_MODEL), D_FF),
        "final_norm_g": gain((D_MODEL,)),
    }


def reference(x, c, ctx, c_ctx, norm_mix_g, norm_ffn_g, mod_w, mod_b, in_w, in_b, hy_conv_w, hy_conv_b,
              hy_w1, hy_b1, hy_w2, hy_b2, hy_w3, hy_b3, hy_freq, hy_w4, hy_skip, hy_norm_g,
              hg_lb_logits, hg_norm_g, out_w, pool_w, pool_b, pool_scale,
              ffn_up_w, ffn_conv_w, ffn_conv_b, ffn_down_w, final_norm_g):
    lbs = jnp.cumsum(jax.nn.softmax(hg_lb_logits.astype(jnp.float32), axis=0), axis=0)
    for l in range(DEPTH):
        sh1, sc1, g1, sh2, sc2, g2 = adaln(c, mod_w[l], mod_b[l])
        h = rmsnorm(x, norm_mix_g[l]) * (1.0 + sc1) + sh1
        if l % 2 == 0:
            e = l // 2
            sh_c, sc_c = adaln(c_ctx[None], mod_w[l], mod_b[l])[:2]
            hc = rmsnorm(ctx, norm_mix_g[l]) * (1.0 + sc_c) + sh_c
            pc = hc @ in_w[e, :, HG_I0:HG_I0 + 3 * HG_D] + in_b[e, HG_I0:HG_I0 + 3 * HG_D]
            s0_fw, s0_bw = hgrn_context_states(*jnp.split(pc, 3, axis=-1), lbs[e])
            proj = h @ in_w[e] + in_b[e]
            filt = (hy_w1[e], hy_b1[e], hy_w2[e], hy_b2[e], hy_w3[e], hy_b3[e], hy_freq[e], hy_w4[e])
            y_hy = hyena_mixer(proj[..., :HG_Q0], hy_conv_w[e], hy_conv_b[e], filt, hy_skip[e], hy_norm_g[e])
            q, i, f_fw, f_bw, g = jnp.split(proj[..., HG_Q0:], 5, axis=-1)
            y_hg = hgrn_mixer(q, i, f_fw, f_bw, g, lbs[e], hg_norm_g[e], s0_fw, s0_bw)
            y = jnp.concatenate([y_hy, y_hg], axis=-1) @ out_w[e]
        else:
            od = l // 2
            y = pool_mixer(h, pool_w[od], pool_b[od], pool_scale[od])
        x = x + g1 * y
        h = rmsnorm(x, norm_ffn_g[l]) * (1.0 + sc2) + sh2
        x = x + g2 * conv_ffn(h, ffn_up_w[l], ffn_conv_w[l], ffn_conv_b[l], ffn_down_w[l])
    return rmsnorm(x, final_norm_g)
```

```cpp
#include <hip/hip_runtime.h>
#include <hip/hip_cooperative_groups.h>
#include <cstdio>
namespace cg = cooperative_groups;

#define LAS __attribute__((address_space(3)))
typedef unsigned short bf16_t;
typedef short bf16x8 __attribute__((ext_vector_type(8)));
typedef float f32x4 __attribute__((ext_vector_type(4)));
typedef unsigned u32x4 __attribute__((ext_vector_type(4)));
typedef unsigned u32x2 __attribute__((ext_vector_type(2)));

constexpr int SEQ = 16384, DM = 2048, DFF = 5632, CTXL = 256, NTH = 512;
constexpr int LDS_MAIN = 135168;
constexpr int LDS_BYTES = LDS_MAIN + 16;

constexpr size_t WS_WT_IN = 0;
constexpr size_t WS_WT_OUT = WS_WT_IN + 33554432;
constexpr size_t WS_WT_POOL = WS_WT_OUT + 8388608;
constexpr size_t WS_WT_UP = WS_WT_POOL + 2097152;
constexpr size_t WS_WT_DN = WS_WT_UP + 46137344;
constexpr size_t WS_MODV = WS_WT_DN + 23068672;
constexpr size_t WS_BAR = WS_MODV + 114688;
constexpr size_t WS_LBS = WS_MODV + 131072;
constexpr size_t WS_HA = WS_LBS + 4096;
constexpr size_t WS_BIG = WS_HA + 68157440;
constexpr size_t WS_PROJT = WS_BIG;
constexpr size_t WS_YMIX = WS_BIG;
constexpr size_t WS_PROJG = WS_BIG + 100663296;
constexpr size_t WS_FILT = WS_PROJG + 167772160;
constexpr size_t WS_OFB = WS_FILT;
constexpr size_t WS_Z2 = WS_FILT + 134217728;
constexpr size_t WS_H3PAD = WS_Z2 + 67108864;
constexpr size_t WS_W4PAD = WS_H3PAD + 8388608;
constexpr size_t WS_PCB = WS_W4PAD + 2097152;
constexpr size_t WS_SLOC = WS_PCB + 1572864;
constexpr size_t WS_DLOC = WS_SLOC + 16777216;
constexpr size_t WS_S0 = WS_DLOC + 131072;
constexpr size_t WS_KS = WS_S0 + 1048576;
constexpr size_t WS_YE = WS_KS + 33554432;
constexpr size_t WS_END = WS_YE + 33554432;
constexpr size_t WS_ABUF = WS_BIG;
constexpr size_t WS_UBUF = WS_BIG + 184549376;
constexpr size_t WS_GBUF = WS_UBUF + 184549376;
constexpr size_t WS_PMA = WS_BIG;

struct Params { const float* in[33]; float* out; unsigned char* ws; int ph_lo; int ph_hi; };
typedef const Params __attribute__((address_space(4)))* KP;

__device__ __forceinline__ unsigned cvt_pk_bf16(float lo, float hi) { unsigned r; asm volatile("v_cvt_pk_bf16_f32 %0, %1, %2" : "=v"(r) : "v"(lo), "v"(hi)); return r; }
__device__ __forceinline__ bf16_t f2bf(float f) { return (bf16_t)(cvt_pk_bf16(f, 0.f) & 0xffffu); }
__device__ __forceinline__ float bf2f(bf16_t b) { return __uint_as_float(((unsigned)b) << 16); }
__device__ __forceinline__ void unpack4(const u32x2 r, float (&v)[4]) {
  v[0] = __uint_as_float(r.x << 16); v[1] = __uint_as_float(r.x & 0xffff0000u); v[2] = __uint_as_float(r.y << 16); v[3] = __uint_as_float(r.y & 0xffff0000u);
}
__device__ __forceinline__ int lane_asm() { int l; asm volatile("v_mbcnt_lo_u32_b32 %0, -1, 0\n\tv_mbcnt_hi_u32_b32 %0, -1, %0" : "=v"(l)); return l; }
__device__ __forceinline__ int fresh_tid(int wave_id) { return wave_id * 64 + lane_asm(); }
__device__ __forceinline__ int lane_fresh() { return lane_asm(); }
__device__ __forceinline__ float shfl_xor_l(float v, int m, int lane) { return __int_as_float(__builtin_amdgcn_ds_bpermute((lane ^ m) << 2, __float_as_int(v))); }
__device__ __forceinline__ float shfl_idx(float v, int src) { return __int_as_float(__builtin_amdgcn_ds_bpermute(src << 2, __float_as_int(v))); }
__device__ __forceinline__ float wave_sum(float v) {
  const int lane = lane_fresh();
#pragma unroll
  for (int o = 1; o < 64; o <<= 1) v += shfl_xor_l(v, o, lane);
  return v;
}
__device__ __forceinline__ float sigmoidf_(float x) { return __builtin_amdgcn_rcpf(1.0f + __expf(-x)); }
__device__ __forceinline__ float hw_sin_rev(float r) { return __builtin_amdgcn_sinf(r); }
__device__ __forceinline__ float hw_cos_rev(float r) { return __builtin_amdgcn_cosf(r); }
__device__ __forceinline__ float2 cmul(float2 a, float2 b) { return make_float2(a.x * b.x - a.y * b.y, a.x * b.y + a.y * b.x); }
__device__ __forceinline__ float2 cadd(float2 a, float2 b) { return make_float2(a.x + b.x, a.y + b.y); }
__device__ __forceinline__ float2 csub(float2 a, float2 b) { return make_float2(a.x - b.x, a.y - b.y); }
__device__ __forceinline__ float2 ld_sc1_f2(const float2* p) {
  unsigned long long v = __hip_atomic_load((const unsigned long long*)p, __ATOMIC_RELAXED, __HIP_MEMORY_SCOPE_AGENT);
  return make_float2(__uint_as_float((unsigned)v), __uint_as_float((unsigned)(v >> 32)));
}
__device__ __forceinline__ float ld_sc1_f(const float* p) { return __uint_as_float(__hip_atomic_load((const unsigned*)p, __ATOMIC_RELAXED, __HIP_MEMORY_SCOPE_AGENT)); }

namespace pg8 {
constexpr int BM = 256, BK = 64, HALF = 128, HTB = HALF * BK * 2, NXCD = 8, WGM = 4;
__device__ __forceinline__ int lds_byte(int r, int c) { const int st = (r >> 4) * 2 + (c >> 5), rr = r & 15, cc = c & 31, ob = rr * 64 + cc * 2; return st * 1024 + (ob ^ (((ob >> 9) & 1) << 5)); }
__device__ __forceinline__ void stage_rc(int b, int& R, int& C) { const int st = b / 1024, sb = b % 1024, swz = sb ^ (((sb >> 9) & 1) << 5); R = (st >> 1) * 16 + swz / 64; C = (st & 1) * 32 + (swz % 64) / 2; }
__device__ __forceinline__ int perm32(int rho) { const int n = rho >> 4, i = rho & 15; return 8 * (i >> 2) + 4 * n + (i & 3); }
struct Unit { int pm, pn; };
struct Gemm { const bf16_t* A; const bf16_t* Bt; int M, N, K; };
struct StaticOrder {
  int nM, nN, nwg, G, c;
  __device__ __forceinline__ void init(int M, int N, int G_, int c_) { nM = M / BM; nN = N / BM; nwg = nM * nN; G = G_; c = c_; }
  __device__ __forceinline__ bool next(int i, Unit& u) const {
    const long L = (long)i * G + c; if (L >= nwg) return false;
    int wgid = (int)L; { const int q = nwg / NXCD, r = nwg % NXCD, xcd = wgid % NXCD, off = wgid / NXCD; wgid = (xcd < r ? xcd * (q + 1) : r * (q + 1) + (xcd - r) * q) + off; }
    const int nig = WGM * nN, gid = wgid / nig, fm = gid * WGM, gsz = (nM - fm) < WGM ? (nM - fm) : WGM;
    u.pm = fm + ((wgid % nig) % gsz); u.pn = (wgid % nig) / gsz; return true;
  }
};
struct Epi {
  int kind;
  int perm;
  bf16_t* O; int ldc; const float* bias; int split_cols; size_t split_stride;
  const float* src; float* dst; const float* gate; const float* scale; int coff;
  __device__ __forceinline__ void operator()(const f32x4 (&acc)[2][2][4][2], const Unit& u, int wr, int wc, int fr, int fq) const {
    if (kind == 0) {
      const int row0 = u.pm * BM + wr * 64 + fr; int colt = u.pn * BM; bf16_t* base = O;
      if (split_cols) { const int t = colt / split_cols; base += (size_t)t * split_stride; colt -= t * split_cols; }
      const int col0 = colt + wc * 32 + 8 * fq, bcol0 = u.pn * BM + wc * 32 + 8 * fq;
#pragma unroll
      for (int bj = 0; bj < 2; ++bj) {
        f32x4 b0 = (f32x4){0.f, 0.f, 0.f, 0.f}, b1 = b0;
        if (bias) { b0 = *(const f32x4*)(bias + bcol0 + bj * HALF); b1 = *(const f32x4*)(bias + bcol0 + bj * HALF + 4); }
#pragma unroll
        for (int ai = 0; ai < 2; ++ai)
#pragma unroll
          for (int m = 0; m < 4; ++m) {
            bf16_t* rowp = base + (size_t)(row0 + ai * HALF + m * 16) * ldc + col0 + bj * HALF;
            const f32x4 v0 = acc[ai][bj][m][0] + b0, v1 = acc[ai][bj][m][1] + b1;
            u32x4 o; o.x = cvt_pk_bf16(v0[0], v0[1]); o.y = cvt_pk_bf16(v0[2], v0[3]); o.z = cvt_pk_bf16(v1[0], v1[1]); o.w = cvt_pk_bf16(v1[2], v1[3]);
            *(u32x4*)rowp = o;
          }
      }
    } else if (kind == 1) {
      const int row0 = u.pm * BM + wr * 64 + fr; const int col0 = u.pn * BM + wc * 32 + 8 * fq;
      const float md0 = -3.0701134573253944f, md1 = -15.350567286626973f;
#pragma unroll
      for (int ai = 0; ai < 2; ++ai)
#pragma unroll
        for (int m = 0; m < 4; ++m) {
          const int row = row0 + ai * HALF + m * 16; const int ch = row & 1023;
          const float delta = fabsf(md0 + (float)ch * ((md1 - md0) / 1023.0f));
          const float kf = -delta * (1.0f / 16383.0f);
          float ee[8];
#pragma unroll
          for (int e = 0; e < 8; ++e) ee[e] = __expf(kf * (float)e);
#pragma unroll
          for (int bj = 0; bj < 2; ++bj) {
            const int cb = col0 + bj * HALF;
            const float eb = __expf(kf * (float)cb);
            const f32x4 v0 = acc[ai][bj][m][0] * eb, v1 = acc[ai][bj][m][1] * eb;
            u32x4 o;
            o.x = cvt_pk_bf16(v0[0] * ee[0], v0[1] * ee[1]);
            o.y = cvt_pk_bf16(v0[2] * ee[2], v0[3] * ee[3]);
            o.z = cvt_pk_bf16(v1[0] * ee[4], v1[1] * ee[5]);
            o.w = cvt_pk_bf16(v1[2] * ee[6], v1[3] * ee[7]);
            *(u32x4*)(O + (size_t)row * ldc + cb) = o;
          }
        }
    } else {
      const int row0 = u.pm * BM + wr * 64 + fr, col0 = coff + u.pn * BM + wc * 32 + 4 * fq;
#pragma unroll
      for (int bj = 0; bj < 2; ++bj)
#pragma unroll
        for (int n = 0; n < 2; ++n) {
          const int c = col0 + bj * HALF + n * 16;
          f32x4 mul = *(const f32x4*)(gate + c);
          f32x4 add = (f32x4){0.f, 0.f, 0.f, 0.f};
          if (scale) mul = mul * *(const f32x4*)(scale + c);
          if (bias) add = *(const f32x4*)(bias + c) * mul;
#pragma unroll
          for (int ai = 0; ai < 2; ++ai)
#pragma unroll
            for (int m = 0; m < 4; ++m) {
              const size_t off = (size_t)(row0 + ai * HALF + m * 16) * DM + c;
              const f32x4 s = *(const f32x4*)(src + off);
              *(f32x4*)(dst + off) = acc[ai][bj][m][n] * mul + add + s;
            }
        }
    }
  }
};

__device__ __forceinline__ void gemm_phase(LAS unsigned char* lds, const Gemm g, const StaticOrder& S, const Epi& E, const int tid) {
  const int wid = __builtin_amdgcn_readfirstlane(tid >> 6), lane = tid & 63, wr = wid >> 2, wc = wid & 3, fr = lane & 15, fq = lane >> 4;
  const int K = g.K, nt = K / BK;
  unsigned voffA[2], voffB[2];
#pragma unroll
  for (int i = 0; i < 2; ++i) { int R, C; stage_rc(tid * 16 + i * 8192, R, C); const int Rb = E.perm ? ((R & ~31) + perm32(R & 31)) : R;
    voffA[i] = (unsigned)(R * K + C) * 2u; voffB[i] = (unsigned)(Rb * K + C) * 2u; }
  const size_t kstep = (size_t)(BK * 2);
  const size_t hstep = (size_t)HALF * K * 2;
  const size_t tstep = 2 * hstep;
  const unsigned ldsw = (unsigned)wid * 1024u;
  const int aoff = lds_byte(wr * 64 + fr, fq * 8), boff = lds_byte(wc * 32 + fr, fq * 8);
#define PG8_SA(b, h) (((b) * 2 + (h)) * HTB)
#define PG8_SB(b, h) ((4 + (b) * 2 + (h)) * HTB)
#define PG8_STAGE(bufoff, gbase, voff) do { _Pragma("unroll") for (int _i = 0; _i < 2; ++_i) \
    __builtin_amdgcn_global_load_lds((const unsigned*)((const char*)(gbase) + (voff)[_i]), (LAS unsigned*)(lds + (bufoff) + ldsw + _i * 8192), 16, 0, 0); } while (0)
#define PG8_LDA(dst, b, h) do { _Pragma("unroll") for (int m = 0; m < 4; ++m) _Pragma("unroll") for (int k = 0; k < 2; ++k) dst[m][k] = *(const LAS bf16x8*)(lds + PG8_SA(b, h) + aoff + m * 2048 + k * 1024); } while (0)
#define PG8_LDB(dst, b, h) do { _Pragma("unroll") for (int n = 0; n < 2; ++n) _Pragma("unroll") for (int k = 0; k < 2; ++k) dst[n][k] = *(const LAS bf16x8*)(lds + PG8_SB(b, h) + boff + n * 2048 + k * 1024); } while (0)
#define PG8_MMA(ai, bj, At, Bt) do { __builtin_amdgcn_s_setprio(1); _Pragma("unroll") for (int m = 0; m < 4; ++m) _Pragma("unroll") for (int n = 0; n < 2; ++n) _Pragma("unroll") for (int k = 0; k < 2; ++k) \
    acc[ai][bj][m][n] = __builtin_amdgcn_mfma_f32_16x16x32_bf16(Bt[n][k], At[m][k], acc[ai][bj][m][n], 0, 0, 0); __builtin_amdgcn_s_setprio(0); } while (0)
#define PG8_WAIT_V(n) asm volatile("s_waitcnt vmcnt(" #n ")" ::: "memory")
#define PG8_WAIT_L(n) asm volatile("s_waitcnt lgkmcnt(" #n ")" ::: "memory")
#define PG8_BAR __builtin_amdgcn_s_barrier()
#define PG8_SCHED __builtin_amdgcn_sched_barrier(0)
  Unit cur, nxt; int ui = 0;
  if (!S.next(0, cur)) return;
  f32x4 acc[2][2][4][2];
#pragma unroll
  for (int a = 0; a < 2; ++a)
#pragma unroll
    for (int b = 0; b < 2; ++b)
#pragma unroll
      for (int m = 0; m < 4; ++m)
#pragma unroll
        for (int n = 0; n < 2; ++n) acc[a][b][m][n] = (f32x4){0.f, 0.f, 0.f, 0.f};
  bf16x8 At[4][2], B0[2][2], B1[2][2];
  const char* cA = (const char*)g.A + (size_t)cur.pm * tstep; const char* cB = (const char*)g.Bt + (size_t)cur.pn * tstep;
  PG8_STAGE(PG8_SB(0, 0), cB, voffB); PG8_STAGE(PG8_SA(0, 0), cA, voffA); PG8_STAGE(PG8_SB(0, 1), cB + hstep, voffB); PG8_STAGE(PG8_SA(0, 1), cA + hstep, voffA);
  if (wr == 1) PG8_BAR;
  PG8_WAIT_V(4); PG8_BAR;
  PG8_STAGE(PG8_SB(1, 0), cB + kstep, voffB); PG8_STAGE(PG8_SA(1, 0), cA + kstep, voffA); PG8_STAGE(PG8_SB(1, 1), cB + hstep + kstep, voffB);
  PG8_WAIT_V(6); PG8_BAR;
  for (;;) {
    const bool has_next = S.next(ui + 1, nxt);
    const char* nA = has_next ? (const char*)g.A + (size_t)nxt.pm * tstep : cA; const char* nB = has_next ? (const char*)g.Bt + (size_t)nxt.pn * tstep : cB;
    for (int t = 0; t < nt; t += 2) {
      const bool last = (t == nt - 2);
      const char* a1 = cA + (size_t)(t + 1) * kstep;
      const char* a2 = last ? nA : cA + (size_t)(t + 2) * kstep; const char* b2 = last ? nB : cB + (size_t)(t + 2) * kstep;
      const char* a3 = a2 + kstep; const char* b3 = b2 + kstep;
      PG8_LDB(B0, 0, 0); PG8_SCHED; PG8_LDA(At, 0, 0); PG8_STAGE(PG8_SA(1, 1), a1 + hstep, voffA);
      PG8_WAIT_L(8); PG8_BAR; PG8_WAIT_L(0); PG8_MMA(0, 0, At, B0); PG8_BAR; PG8_SCHED;
      PG8_LDB(B1, 0, 1); PG8_STAGE(PG8_SB(0, 0), b2, voffB);
      PG8_BAR; PG8_WAIT_L(0); PG8_MMA(0, 1, At, B1); PG8_BAR;
      PG8_LDA(At, 0, 1); PG8_STAGE(PG8_SA(0, 0), a2, voffA);
      PG8_BAR; PG8_WAIT_L(0); PG8_MMA(1, 0, At, B0); PG8_BAR; PG8_SCHED;
      PG8_STAGE(PG8_SB(0, 1), b2 + hstep, voffB);
      PG8_WAIT_V(6); PG8_BAR; PG8_MMA(1, 1, At, B1); PG8_BAR;
      PG8_LDB(B0, 1, 0); PG8_SCHED; PG8_LDA(At, 1, 0); PG8_STAGE(PG8_SA(0, 1), a2 + hstep, voffA);
      PG8_WAIT_L(8); PG8_BAR; PG8_WAIT_L(0); PG8_MMA(0, 0, At, B0); PG8_BAR; PG8_SCHED;
      PG8_LDB(B1, 1, 1); PG8_STAGE(PG8_SB(1, 0), b3, voffB);
      PG8_BAR; PG8_WAIT_L(0); PG8_MMA(0, 1, At, B1); PG8_BAR;
      PG8_LDA(At, 1, 1); PG8_STAGE(PG8_SA(1, 0), a3, voffA);
      PG8_BAR; PG8_WAIT_L(0); PG8_MMA(1, 0, At, B0); PG8_BAR; PG8_SCHED;
      PG8_STAGE(PG8_SB(1, 1), b3 + hstep, voffB);
      PG8_WAIT_V(6); PG8_BAR; PG8_MMA(1, 1, At, B1); PG8_BAR;
    }
    E(acc, cur, wr, wc, fr, fq);
    if (!has_next) break;
#pragma unroll
    for (int a = 0; a < 2; ++a)
#pragma unroll
      for (int b = 0; b < 2; ++b)
#pragma unroll
        for (int m = 0; m < 4; ++m)
#pragma unroll
          for (int n = 0; n < 2; ++n) acc[a][b][m][n] = (f32x4){0.f, 0.f, 0.f, 0.f};
    cur = nxt; cA = nA; cB = nB; ++ui;
  }
  PG8_WAIT_V(0);
  if (wr == 0) PG8_BAR;
  PG8_BAR;
#undef PG8_SA
#undef PG8_SB
#undef PG8_STAGE
#undef PG8_LDA
#undef PG8_LDB
#undef PG8_MMA
#undef PG8_WAIT_V
#undef PG8_WAIT_L
#undef PG8_BAR
#undef PG8_SCHED
}
}

__device__ __forceinline__ bool gemm_job(KP p, int ph, int idx, pg8::Gemm& g, pg8::Epi& e) {
  unsigned char* ws = p->ws;
  e.kind = 0; e.perm = 1; e.O = nullptr; e.ldc = 0; e.bias = nullptr; e.split_cols = 0; e.split_stride = 0;
  e.src = nullptr; e.dst = nullptr; e.gate = nullptr; e.scale = nullptr; e.coff = 0;
  const float* modv = (const float*)(ws + WS_MODV);
  const bf16_t* HA = (const bf16_t*)(ws + WS_HA);
  if (ph == 2) {
    const bf16_t* WTI = (const bf16_t*)(ws + WS_WT_IN);
    if (idx == 0) { g.A = WTI; g.Bt = HA; g.M = 3072; g.N = SEQ; g.K = DM; e.O = (bf16_t*)(ws + WS_PROJT); e.ldc = SEQ; return true; }
    if (idx == 1) { g.A = HA; g.Bt = WTI + (size_t)3072 * DM; g.M = SEQ; g.N = 5120; g.K = DM; e.O = (bf16_t*)(ws + WS_PROJG); e.ldc = 5120; e.bias = p->in[9] + 3072; return true; }
    if (idx == 2) { g.A = HA + (size_t)SEQ * DM; g.Bt = WTI + (size_t)4096 * DM; g.M = CTXL; g.N = 3072; g.K = DM; e.O = (bf16_t*)(ws + WS_PCB); e.ldc = 3072; e.bias = p->in[9] + 4096; return true; }
    if (idx == 3) { g.A = (const bf16_t*)(ws + WS_W4PAD); g.Bt = (const bf16_t*)(ws + WS_H3PAD); g.M = 4096; g.N = SEQ; g.K = 256; e.kind = 1; e.O = (bf16_t*)(ws + WS_FILT); e.ldc = SEQ; return true; }
    return false;
  }
  if (ph == 6) {
    if (idx) return false;
    g.A = (const bf16_t*)(ws + WS_YMIX); g.Bt = (const bf16_t*)(ws + WS_WT_OUT); g.M = SEQ; g.N = DM; g.K = DM;
    e.kind = 2; e.perm = 0; e.src = p->in[0]; e.dst = p->out; e.gate = modv + 2 * DM; return true;
  }
  if (ph == 8 || ph == 15) {
    if (idx) return false;
    g.A = HA; g.Bt = (const bf16_t*)(ws + WS_WT_UP); g.M = SEQ; g.N = 2 * DFF; g.K = DM;
    e.O = (bf16_t*)(ws + WS_ABUF); e.ldc = DFF; e.split_cols = DFF; e.split_stride = (size_t)SEQ * DFF; return true;
  }
  if (ph == 10 || ph == 17) {
    if (idx) return false;
    const int l = (ph == 17);
    g.A = (const bf16_t*)(ws + WS_GBUF); g.Bt = (const bf16_t*)(ws + WS_WT_DN); g.M = SEQ; g.N = DM; g.K = DFF;
    e.kind = 2; e.perm = 0; e.src = p->out; e.dst = p->out; e.gate = modv + l * 12288 + 5 * DM; return true;
  }
  if (ph == 13) {
    if (idx >= 4) return false;
    g.A = (const bf16_t*)(ws + WS_PMA) + (size_t)idx * SEQ * 512; g.Bt = (const bf16_t*)(ws + WS_WT_POOL) + (size_t)idx * 512 * 512; g.M = SEQ; g.N = 512; g.K = 512;
    e.kind = 2; e.perm = 0; e.src = p->out; e.dst = p->out; e.gate = modv + 12288 + 2 * DM; e.bias = p->in[26]; e.scale = p->in[27]; e.coff = idx * 512; return true;
  }
  return false;
}

__device__ __forceinline__ void phase_gemm(KP p, int ph, unsigned char* shm, int tid) {
#pragma unroll 1
  for (int it = 0; it < 4; ++it) {
    pg8::Gemm g; pg8::Epi e;
    int idx = it, Ge = (int)gridDim.x, ce = (int)blockIdx.x;
    if (ph == 13) {
      const int G2 = (int)gridDim.x >> 1, hf = (int)blockIdx.x >= G2 ? 1 : 0;
      if (it >= 2) break;
      idx = 2 * it + hf; Ge = G2; ce = (int)blockIdx.x - hf * G2;
    }
    if (ph == 2 && it == 3 && (int)gridDim.x > 24) {
      if ((int)blockIdx.x < 12) break;
      Ge = (int)gridDim.x - 12; ce = (int)blockIdx.x - 12;
    }
    if (!gemm_job(p, ph, idx, g, e)) break;
    pg8::StaticOrder S; S.init(g.M, g.N, Ge, ce);
    pg8::gemm_phase((LAS unsigned char*)shm, g, S, e, tid);
    __syncthreads();
  }
}

__device__ __forceinline__ void tr_item(const float* __restrict__ W, int K, int N, bf16_t* __restrict__ WT, int item, float* scr, int lane) {
  const int nblk = N >> 5; const int kb = item / nblk, nb = item - kb * nblk; const int k0 = kb << 6, n0 = nb << 5;
  float v[32];
#pragma unroll
  for (int i = 0; i < 32; ++i) v[i] = W[(size_t)(k0 + 2 * i + (lane >> 5)) * N + n0 + (lane & 31)];
#pragma unroll
  for (int i = 0; i < 32; ++i) scr[(2 * i + (lane >> 5)) * 33 + (lane & 31)] = v[i];
  __builtin_amdgcn_fence(__ATOMIC_RELEASE, "wavefront"); __builtin_amdgcn_wave_barrier(); __builtin_amdgcn_fence(__ATOMIC_ACQUIRE, "wavefront");
  const int c = lane & 7;
#pragma unroll
  for (int jj = 0; jj < 4; ++jj) { const int n = (lane >> 3) + 8 * jj; const float* s = scr + (8 * c) * 33 + n;
    u32x4 o; o.x = cvt_pk_bf16(s[0], s[33]); o.y = cvt_pk_bf16(s[2 * 33], s[3 * 33]); o.z = cvt_pk_bf16(s[4 * 33], s[5 * 33]); o.w = cvt_pk_bf16(s[6 * 33], s[7 * 33]);
    *(u32x4*)(WT + (size_t)(n0 + n) * K + k0 + 8 * c) = o; }
  __builtin_amdgcn_fence(__ATOMIC_RELEASE, "wavefront"); __builtin_amdgcn_wave_barrier(); __builtin_amdgcn_fence(__ATOMIC_ACQUIRE, "wavefront");
}
__device__ __forceinline__ void tr_jobs(const float* W, int K, int N, bf16_t* WT, float* sm, int tid) {
  const int cnt = (K >> 6) * (N >> 5); const int lane = tid & 63, wv = tid >> 6;
  float* scr = sm + wv * (64 * 33);
#pragma unroll 1
  for (int t = blockIdx.x * 8 + wv; t < cnt; t += gridDim.x * 8) tr_item(W, K, N, WT, t, scr, lane);
  __syncthreads();
}

__device__ __forceinline__ void adaln_unit(KP p, int u, float* sm, int tid) {
  const int l = u >> 7, j0 = (u & 127) * 96;
  const float* c = p->in[1]; const float* cc = p->in[3];
  for (int k = tid; k < DM; k += NTH) { const float a = c[k]; sm[k] = a / (1.0f + expf(-a)); const float b = cc[k]; sm[DM + k] = b / (1.0f + expf(-b)); }
  __syncthreads();
  const int c4 = tid % 24, rg = tid / 24;
  float* red = sm + 2 * DM;
  if (rg < 21) {
    f32x4 a1 = (f32x4){0.f, 0.f, 0.f, 0.f}, a2 = a1;
    const float* W = p->in[6] + (size_t)l * DM * 12288 + j0 + 4 * c4;
    for (int k = rg; k < DM; k += 21) { const f32x4 w = *(const f32x4*)(W + (size_t)k * 12288); a1 += sm[k] * w; a2 += sm[DM + k] * w; }
    float* d1 = red + (rg * 2 + 0) * 96 + 4 * c4; d1[0] = a1[0]; d1[1] = a1[1]; d1[2] = a1[2]; d1[3] = a1[3];
    float* d2 = red + (rg * 2 + 1) * 96 + 4 * c4; d2[0] = a2[0]; d2[1] = a2[1]; d2[2] = a2[2]; d2[3] = a2[3];
  }
  __syncthreads();
  if (tid < 192) {
    const int which = tid / 96, j = tid % 96; float s = 0.f;
    for (int r = 0; r < 21; ++r) s += red[(r * 2 + which) * 96 + j];
    s += p->in[7][l * 12288 + j0 + j];
    float* modv = (float*)(p->ws + WS_MODV);
    if (which == 0) modv[l * 12288 + j0 + j] = s; else if (l == 0 && j0 + j < 4096) modv[24576 + j0 + j] = s;
  }
  __syncthreads();
}

__device__ __forceinline__ void hymlp_unit(KP p, int u, int tid) {
  const int lane = tid & 63, wv = tid >> 6; const int t = u * 8 + wv;
  const float tl = (float)t / 16383.0f;
  float z = 0.f;
  if (lane == 0) z = tl;
  else if (lane < 33) {
    const int bi = (lane - 1) & 15;
    const float f = 1e-4f + (float)bi * ((15.0f - 1e-4f) / 15.0f);
    float rev = f * (float)t * (1.0f / 16384.0f); rev = rev - floorf(rev);
    z = (lane < 17) ? hw_cos_rev(rev) : -hw_sin_rev(rev);
  }
  const float* w1 = p->in[12]; const float* b1 = p->in[13]; const float* w2 = p->in[14]; const float* b2 = p->in[15];
  const float* w3 = p->in[16]; const float* b3 = p->in[17]; const float* fr = p->in[18];
  float a = b1[lane];
  for (int i = 0; i < 33; ++i) a += shfl_idx(z, i) * w1[i * 64 + lane];
  float r1 = fr[lane] * a * 0.15915494309189535f; r1 -= floorf(r1);
  float h = hw_sin_rev(r1);
  a = b2[lane];
  for (int i = 0; i < 64; ++i) a += shfl_idx(h, i) * w2[i * 64 + lane];
  r1 = fr[64 + lane] * a * 0.15915494309189535f; r1 -= floorf(r1);
  h = hw_sin_rev(r1);
  a = b3[lane];
  for (int i = 0; i < 64; ++i) a += shfl_idx(h, i) * w3[i * 64 + lane];
  r1 = fr[128 + lane] * a * 0.15915494309189535f; r1 -= floorf(r1);
  h = hw_sin_rev(r1);
  bf16_t* H3 = (bf16_t*)(p->ws + WS_H3PAD) + (size_t)t * 256;
  const bf16_t hi = f2bf(h); const bf16_t lo = f2bf(h - bf2f(hi));
  H3[lane] = hi; H3[64 + lane] = hi; H3[128 + lane] = lo; H3[192 + lane] = 0;
}

__device__ __forceinline__ void phase_prep(KP p, unsigned char* shm, int tid) {
  float* sm = (float*)shm;
  unsigned char* ws = p->ws;
  for (int u = blockIdx.x; u < 256; u += gridDim.x) adaln_unit(p, u, sm, tid);
  for (int u = blockIdx.x; u < 2048; u += gridDim.x) hymlp_unit(p, u, tid);
  for (int i = blockIdx.x * NTH + tid; i < 4096 * 64; i += gridDim.x * NTH) {
    const int k = i >> 12, n = i & 4095; const float w = p->in[19][i];
    const bf16_t hi = f2bf(w), lo = f2bf(w - bf2f(hi));
    bf16_t* d = (bf16_t*)(ws + WS_W4PAD) + (size_t)n * 256 + k; d[0] = hi; d[64] = lo; d[128] = hi; d[192] = 0;
  }
  if (blockIdx.x == 0) for (int c = tid; c < 1024; c += NTH) { const float a0 = p->in[22][c], a1 = p->in[22][1024 + c]; ((float*)(ws + WS_LBS))[c] = 1.0f / (1.0f + expf(a1 - a0)); }
  tr_jobs(p->in[8], DM, 8192, (bf16_t*)(ws + WS_WT_IN), sm, tid);
  tr_jobs(p->in[24], DM, DM, (bf16_t*)(ws + WS_WT_OUT), sm, tid);
  for (int gi = 0; gi < 4; ++gi) tr_jobs(p->in[25] + (size_t)gi * 512 * 512, 512, 512, (bf16_t*)(ws + WS_WT_POOL) + (size_t)gi * 512 * 512, sm, tid);
  tr_jobs(p->in[28], DM, 2 * DFF, (bf16_t*)(ws + WS_WT_UP), sm, tid);
  tr_jobs(p->in[31], DFF, DM, (bf16_t*)(ws + WS_WT_DN), sm, tid);
}

__device__ __forceinline__ void norm_rows(const float* src, int nrows, const float* gam, const float* sc, const float* sh, bf16_t* dst, int tid) {
  const int lane = tid & 63; const int gw = blockIdx.x * 8 + (tid >> 6), nw = gridDim.x * 8;
#pragma unroll 1
  for (int r0 = gw; r0 < nrows; r0 += 4 * nw) {
    f32x4 v[4][8]; float ss[4]; int rr[4]; bool ok[4];
#pragma unroll
    for (int q = 0; q < 4; ++q) { const int r = r0 + q * nw; ok[q] = r < nrows; rr[q] = ok[q] ? r : r0; }
#pragma unroll
    for (int q = 0; q < 4; ++q) { const f32x4* xr = (const f32x4*)(src + (size_t)rr[q] * DM) + lane;
#pragma unroll
      for (int j = 0; j < 8; ++j) v[q][j] = xr[64 * j]; }
#pragma unroll
    for (int q = 0; q < 4; ++q) { float s = 0.f;
#pragma unroll
      for (int j = 0; j < 8; ++j) s += v[q][j][0] * v[q][j][0] + v[q][j][1] * v[q][j][1] + v[q][j][2] * v[q][j][2] + v[q][j][3] * v[q][j][3];
      ss[q] = rsqrtf(wave_sum(s) * (1.0f / DM) + 1e-6f); }
#pragma unroll
    for (int j = 0; j < 8; ++j) {
      const int c = 4 * (lane + 64 * j);
      const f32x4 mul = *(const f32x4*)(gam + c) * (1.0f + *(const f32x4*)(sc + c)); const f32x4 add = *(const f32x4*)(sh + c);
#pragma unroll
      for (int q = 0; q < 4; ++q) if (ok[q]) {
        const f32x4 h = v[q][j] * ss[q] * mul + add; u32x2 w; w.x = cvt_pk_bf16(h[0], h[1]); w.y = cvt_pk_bf16(h[2], h[3]);
        ((u32x2*)(dst + (size_t)rr[q] * DM) + lane)[64 * j] = w;
      }
    }
  }
}
__device__ __forceinline__ void final_norm(float* x, const float* gam, int tid) {
  const int lane = tid & 63; const int gw = blockIdx.x * 8 + (tid >> 6), nw = gridDim.x * 8;
  for (int r = gw; r < SEQ; r += nw) {
    f32x4* xr = (f32x4*)(x + (size_t)r * DM) + lane;
    f32x4 v[8]; float ss = 0.f;
#pragma unroll
    for (int j = 0; j < 8; ++j) { v[j] = xr[64 * j]; ss += v[j][0] * v[j][0] + v[j][1] * v[j][1] + v[j][2] * v[j][2] + v[j][3] * v[j][3]; }
    const float rstd = rsqrtf(wave_sum(ss) * (1.0f / DM) + 1e-6f);
#pragma unroll
    for (int j = 0; j < 8; ++j) xr[64 * j] = v[j] * rstd * *(const f32x4*)(gam + 4 * (lane + 64 * j));
  }
}
__device__ __forceinline__ void phase_norm(KP p, int ph, unsigned char* shm, int tid) {
  unsigned char* ws = p->ws; const float* modv = (const float*)(ws + WS_MODV); bf16_t* HA = (bf16_t*)(ws + WS_HA);
  if (ph == 18) { final_norm(p->out, p->in[32], tid); return; }
  const int l = (ph >= 11), ffn = (ph == 7 || ph == 14);
  const float* gam = (ffn ? p->in[5] : p->in[4]) + l * DM;
  const float* sh = modv + l * 12288 + (ffn ? 3 : 0) * DM; const float* sc = sh + DM;
  norm_rows(ph == 1 ? p->in[0] : p->out, SEQ, gam, sc, sh, HA, tid);
  if (ph == 1) norm_rows(p->in[2], CTXL, gam, modv + 24576 + DM, modv + 24576, HA + (size_t)SEQ * DM, tid);
  if (ph == 11) tr_jobs(p->in[31] + (size_t)DFF * DM, DFF, DM, (bf16_t*)(ws + WS_WT_DN), (float*)shm, tid);
}

__device__ __forceinline__ constexpr int FP(int n) { return n + (n >> 5); }
__device__ __forceinline__ constexpr float tw32c(int k) {
  switch (k & 15) { case 0: return 1.0f; case 1: return 0.98078528040323044913f; case 2: return 0.92387953251128675613f; case 3: return 0.83146961230254523708f;
    case 4: return 0.70710678118654752440f; case 5: return 0.55557023301960222474f; case 6: return 0.38268343236508977173f; case 7: return 0.19509032201612826785f;
    case 8: return 0.0f; case 9: return -0.19509032201612826785f; case 10: return -0.38268343236508977173f; case 11: return -0.55557023301960222474f;
    case 12: return -0.70710678118654752440f; case 13: return -0.83146961230254523708f; case 14: return -0.92387953251128675613f; default: return -0.98078528040323044913f; }
}
__device__ __forceinline__ constexpr float tw32s(int k) { return tw32c((k + 24) & 31 & 15) * ((((k + 24) & 31) >= 16) ? -1.0f : 1.0f); }
__device__ __forceinline__ constexpr int brev_n(int x, int bits) { int r = 0; for (int b = 0; b < bits; ++b) r |= ((x >> b) & 1) << (bits - 1 - b); return r; }
template <int R, int LOG, bool INV> __device__ __forceinline__ void reg_fft(float2 (&v)[R]) {
#pragma unroll
  for (int st = 0; st < LOG; ++st) {
    const int ln = R >> st, h = ln >> 1;
#pragma unroll
    for (int blk = 0; blk < R; blk += ln)
#pragma unroll
      for (int j = 0; j < h; ++j) {
        const float2 a = v[blk + j], b = v[blk + j + h];
        v[blk + j] = cadd(a, b);
        const float2 d = csub(a, b);
        const int tk = j * (32 / ln);
        if (tk == 0) v[blk + j + h] = d;
        else if (tk == 8) v[blk + j + h] = INV ? make_float2(-d.y, d.x) : make_float2(d.y, -d.x);
        else { const float c = tw32c(tk), s = tw32s(tk); v[blk + j + h] = cmul(d, make_float2(c, INV ? s : -s)); }
      }
    __builtin_amdgcn_sched_barrier(0);
  }
}
__device__ __forceinline__ void fft_fwd(float2* X, int tid) {
#pragma unroll 1
  for (int it = 0; it < 2; ++it) {
    const int i = tid + NTH * it;
    float2* xb = X + FP(i);
    float2 v[16];
#pragma unroll
    for (int m = 0; m < 16; ++m) v[m] = xb[1056 * m];
    __builtin_amdgcn_sched_barrier(0);
    reg_fft<16, 4, false>(v);
    float rv = (float)i * (1.0f / 16384.0f); asm volatile("" : "+v"(rv));
    const float2 w1 = make_float2(hw_cos_rev(rv), -hw_sin_rev(rv)); float2 w = w1;
    xb[0] = v[0];
#pragma unroll
    for (int r = 1; r < 16; ++r) { const int x = brev_n(r, 4); xb[1056 * r] = cmul(v[x], w); w = cmul(w, w1);  if ((r & 3) == 3) __builtin_amdgcn_sched_barrier(0); }
  }
  __syncthreads();
  {
    const int blk = tid >> 5, i = tid & 31;
    float2* xb = X + blk * 1056 + i;
    float2 v[32];
#pragma unroll
    for (int m = 0; m < 32; ++m) v[m] = xb[33 * m];
    __builtin_amdgcn_sched_barrier(0);
    reg_fft<32, 5, false>(v);
    float rv = (float)i * (1.0f / 1024.0f); asm volatile("" : "+v"(rv));
    const float2 w1 = make_float2(hw_cos_rev(rv), -hw_sin_rev(rv)); float2 w = w1;
    xb[0] = v[0];
#pragma unroll
    for (int r = 1; r < 32; ++r) { const int x = brev_n(r, 5); xb[33 * r] = cmul(v[x], w); w = cmul(w, w1);  if ((r & 3) == 3) __builtin_amdgcn_sched_barrier(0); }
  }
  __syncthreads();
  {
    float2* xb = X + 33 * tid;
    float2 v[32];
#pragma unroll
    for (int c = 0; c < 32; ++c) v[c] = xb[c];
    __builtin_amdgcn_sched_barrier(0);
    reg_fft<32, 5, false>(v);
#pragma unroll
    for (int x = 0; x < 32; ++x) xb[brev_n(x, 5)] = v[x];
  }
  __syncthreads();
}
__device__ __forceinline__ void fft_inv(float2* X, int tid) {
  {
    float2* xb = X + 33 * tid;
    float2 v[32];
#pragma unroll
    for (int c = 0; c < 32; ++c) v[c] = xb[c];
    __builtin_amdgcn_sched_barrier(0);
    reg_fft<32, 5, true>(v);
#pragma unroll
    for (int x = 0; x < 32; ++x) xb[brev_n(x, 5)] = v[x];
  }
  __syncthreads();
  {
    const int blk = tid >> 5, i = tid & 31;
    float2* xb = X + blk * 1056 + i;
    float2 v[32];
    float rv = (float)i * (1.0f / 1024.0f); asm volatile("" : "+v"(rv));
    const float2 w1 = make_float2(hw_cos_rev(rv), hw_sin_rev(rv)); float2 w = w1;
    v[0] = xb[0];
#pragma unroll
    for (int r = 1; r < 32; ++r) { v[r] = cmul(xb[33 * r], w); w = cmul(w, w1);  if ((r & 3) == 3) __builtin_amdgcn_sched_barrier(0); }
    __builtin_amdgcn_sched_barrier(0);
    reg_fft<32, 5, true>(v);
#pragma unroll
    for (int x = 0; x < 32; ++x) xb[33 * brev_n(x, 5)] = v[x];
  }
  __syncthreads();
#pragma unroll 1
  for (int it = 0; it < 2; ++it) {
    const int i = tid + NTH * it;
    float2* xb = X + FP(i);
    float2 v[16];
    float rv = (float)i * (1.0f / 16384.0f); asm volatile("" : "+v"(rv));
    const float2 w1 = make_float2(hw_cos_rev(rv), hw_sin_rev(rv)); float2 w = w1;
    v[0] = xb[0];
#pragma unroll
    for (int r = 1; r < 16; ++r) { v[r] = cmul(xb[1056 * r], w); w = cmul(w, w1);  if ((r & 3) == 3) __builtin_amdgcn_sched_barrier(0); }
    __builtin_amdgcn_sched_barrier(0);
    reg_fft<16, 4, true>(v);
#pragma unroll
    for (int x = 0; x < 16; ++x) xb[1056 * brev_n(x, 4)] = v[x];
  }
  __syncthreads();
}
__device__ __forceinline__ int fpos(int k) { return ((k & 15) << 10) | (((k >> 4) & 31) << 5) | (k >> 9); }

struct ConvC { float w0, w1, w2, cb, ib; };
__device__ __forceinline__ float uni(float v) { return __uint_as_float(__builtin_amdgcn_readfirstlane(__float_as_uint(v))); }
__device__ __forceinline__ ConvC conv_consts(KP p, int r) { ConvC c; c.w0 = uni(p->in[10][r]); c.w1 = uni(p->in[10][3072 + r]); c.w2 = uni(p->in[10][6144 + r]); c.cb = uni(p->in[11][r]); c.ib = uni(p->in[9][r]); return c; }
__device__ __forceinline__ float conv3(const bf16_t* row, int n, const ConvC& c) {
  const float ce = bf2f(row[n]) + c.ib; const float l0 = bf2f(row[n > 0 ? n - 1 : 0]) + c.ib; const float r0 = bf2f(row[n < SEQ - 1 ? n + 1 : SEQ - 1]) + c.ib;
  const float le = n > 0 ? l0 : 0.f; const float ri = n < SEQ - 1 ? r0 : 0.f;
  return c.w0 * le + c.w1 * ce + c.w2 * ri + c.cb;
}

typedef _Float16 h16x2 __attribute__((ext_vector_type(2)));
__device__ __forceinline__ unsigned pack_h2(float a, float b) { return cvt_pk_bf16(a, b); }
__device__ __forceinline__ float2 unpack_h2(unsigned w) { return make_float2(__uint_as_float(w << 16), __uint_as_float(w & 0xffff0000u)); }
__device__ __forceinline__ void ld32_sc0(const unsigned* p, u32x4 (&r)[8]) {
  asm volatile(
    "global_load_dwordx4 %0, %8, off sc0 sc1\n\t"
    "global_load_dwordx4 %1, %8, off offset:16 sc0 sc1\n\t"
    "global_load_dwordx4 %2, %8, off offset:32 sc0 sc1\n\t"
    "global_load_dwordx4 %3, %8, off offset:48 sc0 sc1\n\t"
    "global_load_dwordx4 %4, %8, off offset:64 sc0 sc1\n\t"
    "global_load_dwordx4 %5, %8, off offset:80 sc0 sc1\n\t"
    "global_load_dwordx4 %6, %8, off offset:96 sc0 sc1\n\t"
    "global_load_dwordx4 %7, %8, off offset:112 sc0 sc1\n\t"
    "s_waitcnt vmcnt(0)"
    : "=&v"(r[0]), "=&v"(r[1]), "=&v"(r[2]), "=&v"(r[3]), "=&v"(r[4]), "=&v"(r[5]), "=&v"(r[6]), "=&v"(r[7]) : "v"(p) : "memory");
}
struct Row32 { u32x4 q[4]; };
__device__ __forceinline__ Row32 ld_row32(const bf16_t* p) { Row32 r;
#pragma unroll
  for (int i = 0; i < 4; ++i) r.q[i] = *(const u32x4*)(p + 8 * i);
  return r; }
__device__ __forceinline__ float row_get(const Row32& r, int e) { const unsigned w = r.q[e >> 3][(e >> 1) & 3]; return (e & 1) ? __uint_as_float(w & 0xffff0000u) : __uint_as_float(w << 16); }
__device__ __forceinline__ void row_edges(const bf16_t* row, int tid, float ib, float& left, float& right) {
  const float l0 = bf2f(row[tid > 0 ? 32 * tid - 1 : 0]) + ib; left = tid > 0 ? l0 : 0.f;
  const float r0 = bf2f(row[tid < 511 ? 32 * tid + 32 : SEQ - 1]) + ib; right = tid < 511 ? r0 : 0.f;
}
__device__ __forceinline__ float conv_at(const Row32& r, int c, float left, float right, const ConvC& k) {
  const float ce = row_get(r, c) + k.ib;
  const float le = c > 0 ? row_get(r, c > 0 ? c - 1 : 0) + k.ib : left;
  const float ri = c < 31 ? row_get(r, c < 31 ? c + 1 : 31) + k.ib : right;
  return k.w0 * le + k.w1 * ce + k.w2 * ri + k.cb;
}

template <int MODE> __device__ __forceinline__ void hyena_unit(KP p, int pair, float2* X, int wave_id) {
  unsigned char* ws = p->ws;
  const int ca = 2 * pair, cb = ca + 1;
  const bf16_t* PT = (const bf16_t*)(ws + WS_PROJT);
  const bf16_t* FT = (const bf16_t*)(ws + WS_FILT);
  bf16_t* Z2 = (bf16_t*)(ws + WS_Z2);
  bf16_t* za = MODE ? (bf16_t*)(ws + WS_END) + (size_t)blockIdx.x * 2 * SEQ : Z2 + (size_t)ca * SEQ; bf16_t* zb = MODE ? za + SEQ : Z2 + (size_t)cb * SEQ;
  unsigned* KS = (unsigned*)(ws + WS_KS) + (size_t)blockIdx.x * SEQ;
  unsigned* YE = (unsigned*)(ws + WS_YE) + (size_t)blockIdx.x * SEQ;
  const ConvC cva = conv_consts(p, ca), cvb = conv_consts(p, cb);
  const bf16_t* va = PT + (size_t)ca * SEQ; const bf16_t* vb = PT + (size_t)cb * SEQ;
  const float invN = 1.0f / 32768.0f;
#pragma unroll 1
  for (int ord = 0; ord < 2; ++ord) {
    const ConvC cga = conv_consts(p, 1024 * (ord + 1) + ca), cgb = conv_consts(p, 1024 * (ord + 1) + cb);
    const bf16_t* ga = PT + (size_t)(1024 * (ord + 1) + ca) * SEQ; const bf16_t* gb = PT + (size_t)(1024 * (ord + 1) + cb) * SEQ;
    const float ska = uni(p->in[20][ord * 1024 + ca]), skb = uni(p->in[20][ord * 1024 + cb]);
    const bf16_t* faf = FT + (size_t)(ord * 2048 + ca) * SEQ; const bf16_t* fbf = FT + (size_t)(ord * 2048 + cb) * SEQ;
    const bf16_t* fab = FT + (size_t)(ord * 2048 + 1024 + ca) * SEQ; const bf16_t* fbb = FT + (size_t)(ord * 2048 + 1024 + cb) * SEQ;
    u32x4 yreg[7];
#pragma unroll
    for (int i = 0; i < 7; ++i) yreg[i] = (u32x4){0u, 0u, 0u, 0u};
#pragma unroll
    for (int half = 0; half < 2; ++half) {
      int tid = fresh_tid(wave_id);
      float2* xc; int n0;
#define HY_FRESH() do { tid = fresh_tid(wave_id); xc = X + 33 * tid; n0 = 32 * tid; } while (0)
      HY_FRESH();
      const float twr = half ? invN : 0.f;
      const float sgn = half ? -1.f : 1.f;
      {
        const Row32 rfa = ld_row32(faf + n0), rfb = ld_row32(fbf + n0);
        const Row32 rba = ld_row32(fab + (SEQ - 32 - n0)), rbb = ld_row32(fbb + (SEQ - 32 - n0));
        const int ex = tid ? SEQ - n0 : 0;
        float ea = bf2f(fab[ex]), eb = bf2f(fbb[ex]); ea = tid ? ea : 0.f; eb = tid ? eb : 0.f;
#pragma unroll
        for (int c = 0; c < 32; ++c) {
          const float kaf = row_get(rfa, c), kbf = row_get(rfb, c);
          const float kab = c ? row_get(rba, c ? 32 - c : 0) : ea, kbb = c ? row_get(rbb, c ? 32 - c : 0) : eb;
          const float r = (float)(n0 + c) * twr;
          xc[c] = cmul(make_float2(kaf + sgn * kab, kbf + sgn * kbb), make_float2(hw_cos_rev(r), -hw_sin_rev(r)));
        }
      }
      __syncthreads();
      if (MODE != 2) fft_fwd(X, tid);
      HY_FRESH();
      u32x4 kown[8];
#pragma unroll
      for (int i = 0; i < 8; ++i) { u32x4 o;
#pragma unroll
        for (int k = 0; k < 4; ++k) { const float2 a = xc[4 * i + k]; o[k] = pack_h2(a.x * 0.0625f, a.y * 0.0625f); }
        *(u32x4*)(KS + n0 + 4 * i) = o; kown[i] = o; }
      __syncthreads();
      HY_FRESH();
      if (ord == 0) {
        const Row32 ra = ld_row32(va + n0), rb = ld_row32(vb + n0);
        float la, ra_, lb, rb_; row_edges(va, tid, cva.ib, la, ra_); row_edges(vb, tid, cvb.ib, lb, rb_);
#pragma unroll
        for (int c = 0; c < 32; ++c) {
          const float r = (float)(n0 + c) * twr;
          xc[c] = cmul(make_float2(conv_at(ra, c, la, ra_, cva), conv_at(rb, c, lb, rb_, cvb)), make_float2(hw_cos_rev(r), -hw_sin_rev(r)));
        }
      } else {
#pragma unroll
        for (int g = 0; g < 8; ++g) {
          float a[4], b[4]; unpack4(*(const u32x2*)(za + n0 + 4 * g), a); unpack4(*(const u32x2*)(zb + n0 + 4 * g), b);
#pragma unroll
          for (int k = 0; k < 4; ++k) { const float r = (float)(n0 + 4 * g + k) * twr; xc[4 * g + k] = cmul(make_float2(a[k], b[k]), make_float2(hw_cos_rev(r), -hw_sin_rev(r))); }
        }
      }
      __syncthreads();
      if (MODE != 2) fft_fwd(X, tid);
      {
        HY_FRESH();
        const int jb = ((tid >> 5) & 15) | ((tid & 31) << 4);
        const int jp0 = half ? (SEQ - 1 - jb) : ((SEQ - jb) & (SEQ - 1));
        const bool special = (half == 0) && (tid == 0);
        const int chq = special ? 0 : (fpos(jp0) >> 5);
        const float2* xq = X + 33 * chq;
        u32x4 kq[8], kpv[8];
        ld32_sc0(KS + 32 * chq, kq);
        if (half) ld32_sc0(KS + n0, kpv);
        else {
#pragma unroll
          for (int i = 0; i < 8; ++i) kpv[i] = kown[i]; }
        float2 wr[32];
#pragma unroll
        for (int i = 0; i < 8; ++i) {
          const u32x4 kp = kpv[i];
#pragma unroll
          for (int k = 0; k < 4; ++k) {
            const int c = 4 * i + k;
            const int e1 = 31 - c, e2 = (32 - c) & 31;
            const float2 Zp = xc[c]; float2 Zq = xq[special ? e2 : e1]; Zq.y = -Zq.y;
            const float2 Kp = unpack_h2(kp[k]);
            float2 Kq = unpack_h2(special ? kq[e2 >> 2][e2 & 3] : kq[e1 >> 2][e1 & 3]); Kq.y = -Kq.y;
            const float2 Ua = make_float2(0.5f * (Zp.x + Zq.x), 0.5f * (Zp.y + Zq.y));
            const float2 dz = csub(Zp, Zq); const float2 Ub = make_float2(0.5f * dz.y, -0.5f * dz.x);
            const float2 Ka = make_float2(0.5f * (Kp.x + Kq.x), 0.5f * (Kp.y + Kq.y));
            const float2 dk = csub(Kp, Kq); const float2 Kb = make_float2(0.5f * dk.y, -0.5f * dk.x);
            const float2 P = cmul(Ua, Ka), Q = cmul(Ub, Kb);
            wr[c] = make_float2(P.x - Q.y, P.y + Q.x);
          }
        }
        __syncthreads();
#pragma unroll
        for (int c = 0; c < 32; ++c) xc[c] = wr[c];
      }
      __syncthreads();
      if (MODE != 2) fft_inv(X, tid);
      if (half == 0) {
#pragma unroll
        for (int i = 0; i < 8; ++i) { u32x4 o;
#pragma unroll
        for (int k = 0; k < 4; ++k) { const float2 a = xc[4 * i + k]; o[k] = pack_h2(a.x * (16.0f * invN), a.y * (16.0f * invN)); }
        if (i < 7) yreg[i] = o; else *(u32x4*)(YE + n0 + 28) = o; }
      } else {
        HY_FRESH();
        const Row32 rga = ld_row32(ga + n0), rgb = ld_row32(gb + n0);
        float lga, rga_, lgb, rgb_; row_edges(ga, tid, cga.ib, lga, rga_); row_edges(gb, tid, cgb.ib, lgb, rgb_);
        Row32 ra, rb; float la = 0.f, ra_ = 0.f, lb = 0.f, rb_ = 0.f;
        if (ord == 0) { ra = ld_row32(va + n0); rb = ld_row32(vb + n0); row_edges(va, tid, cva.ib, la, ra_); row_edges(vb, tid, cvb.ib, lb, rb_); }
        u32x4 ylast;
        asm volatile("global_load_dwordx4 %0, %1, off sc0 sc1\n\ts_waitcnt vmcnt(0)" : "=&v"(ylast) : "v"(YE + n0 + 28) : "memory");
#pragma unroll
        for (int g = 0; g < 8; ++g) {
          f32x4 ua4, ub4;
          if (ord == 0) {
#pragma unroll
            for (int k = 0; k < 4; ++k) { ua4[k] = conv_at(ra, 4 * g + k, la, ra_, cva); ub4[k] = conv_at(rb, 4 * g + k, lb, rb_, cvb); }
          } else { float a[4], b[4]; unpack4(*(const u32x2*)(za + n0 + 4 * g), a); unpack4(*(const u32x2*)(zb + n0 + 4 * g), b);
#pragma unroll
            for (int k = 0; k < 4; ++k) { ua4[k] = a[k]; ub4[k] = b[k]; } }
          const u32x4 yew = (g < 7) ? yreg[g < 7 ? g : 0] : ylast;
          f32x4 oa, ob;
#pragma unroll
          for (int k = 0; k < 4; ++k) {
            const int c = 4 * g + k;
            const float r = (float)(n0 + c) * invN;
            const float2 yo = cmul(make_float2(hw_cos_rev(r), hw_sin_rev(r)), xc[c]);
            const float2 ye = unpack_h2(yew[k]);
            const float ya = ye.x + yo.x * (16.0f * invN), yb = ye.y + yo.y * (16.0f * invN);
            oa[k] = conv_at(rga, c, lga, rga_, cga) * (ya + ska * ua4[k]);
            ob[k] = conv_at(rgb, c, lgb, rgb_, cgb) * (yb + skb * ub4[k]);
          }
          { u32x2 wa, wb; wa.x = cvt_pk_bf16(oa[0], oa[1]); wa.y = cvt_pk_bf16(oa[2], oa[3]); wb.x = cvt_pk_bf16(ob[0], ob[1]); wb.y = cvt_pk_bf16(ob[2], ob[3]);
            *(u32x2*)(za + n0 + 4 * g) = wa; *(u32x2*)(zb + n0 + 4 * g) = wb; }
        }
      }
      __syncthreads();
    }
  }
#undef HY_FRESH
}

__device__ __forceinline__ void hy_headnorm_unit(KP p, int u, float* sm, int tid) {
  const int hh = u >> 8, t0 = (u & 255) << 6;
  const bf16_t* Z2 = (const bf16_t*)(p->ws + WS_Z2) + (size_t)(hh * 128) * SEQ + t0;
  for (int i = tid; i < 128 * 16; i += NTH) { const int c = i >> 4, t4 = (i & 15) << 2; float v[4]; unpack4(*(const u32x2*)(Z2 + (size_t)c * SEQ + t4), v); float* d = sm + c * 65 + t4; d[0] = v[0]; d[1] = v[1]; d[2] = v[2]; d[3] = v[3]; }
  __syncthreads();
  float* part = sm + 128 * 65;
  { const int t = tid & 63, pt = tid >> 6; float s = 0.f;
#pragma unroll
    for (int c = 0; c < 16; ++c) { const float v = sm[(pt * 16 + c) * 65 + t]; s += v * v; }
    part[pt * 64 + t] = s; }
  __syncthreads();
  const float* gn = p->in[21] + hh * 128;
  bf16_t* Y = (bf16_t*)(p->ws + WS_YMIX);
  for (int i = tid; i < 64 * 16; i += NTH) {
    const int t = i >> 4, c0 = (i & 15) << 3;
    float s = 0.f;
#pragma unroll
    for (int k = 0; k < 8; ++k) s += part[k * 64 + t];
    const float rstd = rsqrtf(s * (1.0f / 128.0f) + 1e-6f);
    float v[8];
#pragma unroll
    for (int k = 0; k < 8; ++k) v[k] = sm[(c0 + k) * 65 + t] * rstd * gn[c0 + k];
    u32x4 o; o.x = cvt_pk_bf16(v[0], v[1]); o.y = cvt_pk_bf16(v[2], v[3]); o.z = cvt_pk_bf16(v[4], v[5]); o.w = cvt_pk_bf16(v[6], v[7]);
    *(u32x4*)(Y + (size_t)(t0 + t) * DM + hh * 128 + c0) = o;
  }
  __syncthreads();
}

constexpr int HG_QIN = 0, HG_KIN = 17408, HG_KST = 34816, HG_VT = 53248, HG_AM = 71680, HG_ST = 80896, HG_PART = 115712, HG_DEC = 117760;
struct HgSrc { const bf16_t* q; const bf16_t* v; const bf16_t* f; int ld; int len; };

__device__ __forceinline__ void lds_barrier() { asm volatile("s_waitcnt lgkmcnt(0)\n\ts_barrier" ::: "memory"); }
struct HgRaw { unsigned fv[16]; unsigned q2[8]; };
template <bool WITHQ>
__device__ __forceinline__ void hg_load(const HgSrc& s, int dir, int n, int tid, HgRaw& r) {
  const int k = tid & 127, sg = tid >> 7;
  const int sp0 = n * 64 + sg * 16; const int tb = dir ? (s.len - 1 - sp0) : sp0; const int step = dir ? -s.ld : s.ld;
  const size_t ob = (size_t)tb * s.ld + k;
  const bf16_t* pf = s.f + ob; const bf16_t* pv = s.v + ob; const bf16_t* pq = s.q + ob;
#pragma unroll
  for (int j = 0; j < 16; j += 2) {
    const int r0 = j * step, r1 = (j + 1) * step;
    r.fv[j] = (unsigned)pf[r0] | ((unsigned)pv[r0] << 16); r.fv[j + 1] = (unsigned)pf[r1] | ((unsigned)pv[r1] << 16);
    if (WITHQ) r.q2[j >> 1] = (unsigned)pq[r0] | ((unsigned)pq[r1] << 16);
  }
}
template <bool WITHQ>
__device__ __forceinline__ float hg_prep(const HgRaw& r, float lbk, unsigned char* shm, int tid) {
  const int k = tid & 127, sg = tid >> 7;
  bf16_t* QIN = (bf16_t*)(shm + HG_QIN); bf16_t* KIN = (bf16_t*)(shm + HG_KIN); bf16_t* KST = (bf16_t*)(shm + HG_KST); bf16_t* VT = (bf16_t*)(shm + HG_VT);
  float* PART = (float*)(shm + HG_PART); float* DEC = (float*)(shm + HG_DEC);
  float bl[16], kk[16]; float run = 0.f;
#pragma unroll
  for (int j = 0; j < 16; ++j) {
    const float f = lbk + (1.0f - lbk) * sigmoidf_(__uint_as_float(r.fv[j] << 16));
    run += __logf(f); bl[j] = run; kk[j] = 1.0f - f;
  }
  PART[sg * 128 + k] = run;
  lds_barrier();
  float off = 0.f;
#pragma unroll
  for (int g = 0; g < 4; ++g) off += (g < sg) ? PART[g * 128 + k] : 0.f;
  const float tot = PART[k] + PART[128 + k] + PART[256 + k] + PART[384 + k];
  float kst[16];
  const float etot = __expf(tot);
#pragma unroll
  for (int j = 0; j < 16; ++j) {
    const int sl = sg * 16 + j;
    const float b = off + bl[j];
    if (WITHQ) {
      const float qr = (j & 1) ? __uint_as_float(r.q2[j >> 1] & 0xffff0000u) : __uint_as_float(r.q2[j >> 1] << 16);
      const float kin = kk[j] * __expf(-b);
      QIN[sl * 136 + k] = f2bf(qr * sigmoidf_(qr) * __expf(b));
      KIN[sl * 136 + k] = f2bf(kin);
      kst[j] = kin * etot;
    } else kst[j] = kk[j] * __expf(tot - b);
  }
  {
    u32x4 a0, a1, v0, v1;
#pragma unroll
    for (int i = 0; i < 4; ++i) { a0[i] = cvt_pk_bf16(kst[2 * i], kst[2 * i + 1]); a1[i] = cvt_pk_bf16(kst[8 + 2 * i], kst[8 + 2 * i + 1]);
      v0[i] = (r.fv[2 * i] >> 16) | (r.fv[2 * i + 1] & 0xffff0000u); v1[i] = (r.fv[8 + 2 * i] >> 16) | (r.fv[8 + 2 * i + 1] & 0xffff0000u); }
    *(u32x4*)(KST + k * 72 + sg * 16) = a0; *(u32x4*)(KST + k * 72 + sg * 16 + 8) = a1;
    *(u32x4*)(VT + k * 72 + sg * 16) = v0; *(u32x4*)(VT + k * 72 + sg * 16 + 8) = v1;
  }
  if (sg == 0) DEC[k] = etot;
  lds_barrier();
  return tot;
}

__device__ __forceinline__ void hg_state_update(f32x4 (&Sacc)[8], unsigned char* shm, int wv, int fr, int fq) {
  const bf16_t* KST = (const bf16_t*)(shm + HG_KST); const bf16_t* VT = (const bf16_t*)(shm + HG_VT); const float* DEC = (const float*)(shm + HG_DEC);
  float dc[4];
#pragma unroll
  for (int j = 0; j < 4; ++j) dc[j] = DEC[16 * wv + fq * 4 + j];
#pragma unroll
  for (int nt = 0; nt < 8; ++nt)
#pragma unroll
    for (int j = 0; j < 4; ++j) Sacc[nt][j] *= dc[j];
#pragma unroll
  for (int ks = 0; ks < 2; ++ks) {
    const bf16x8 a = *(const bf16x8*)(KST + (16 * wv + fr) * 72 + ks * 32 + fq * 8);
#pragma unroll
    for (int nt = 0; nt < 8; ++nt) {
      const bf16x8 b = *(const bf16x8*)(VT + (nt * 16 + fr) * 72 + ks * 32 + fq * 8);
      Sacc[nt] = __builtin_amdgcn_mfma_f32_16x16x32_bf16(a, b, Sacc[nt], 0, 0, 0);
    }
  }
}
__device__ __forceinline__ void hg_write_st(const f32x4 (&Sacc)[8], unsigned char* shm, int wv, int fr, int fq) {
  bf16_t* ST = (bf16_t*)(shm + HG_ST);
#pragma unroll
  for (int nt = 0; nt < 8; ++nt) {
    u32x2 w; w.x = cvt_pk_bf16(Sacc[nt][0], Sacc[nt][1]); w.y = cvt_pk_bf16(Sacc[nt][2], Sacc[nt][3]);
    *(u32x2*)(ST + (nt * 16 + fr) * 136 + 16 * wv + fq * 4) = w;
  }
}
__device__ __forceinline__ HgSrc hg_src(KP p, int h, int d, bool ctx) {
  HgSrc s;
  if (ctx) { const bf16_t* P = (const bf16_t*)(p->ws + WS_PCB) + h * 128; s.q = P; s.v = P; s.f = P + (1 + d) * 1024; s.ld = 3072; s.len = CTXL; }
  else { const bf16_t* P = (const bf16_t*)(p->ws + WS_PROJG) + h * 128; s.q = P; s.v = P + 1024; s.f = P + (2 + d) * 1024; s.ld = 5120; s.len = SEQ; }
  return s;
}
constexpr int HG_KST2 = HG_QIN, HG_VT2 = HG_ST, HG_PART2 = HG_DEC + 512, HG_DEC2 = HG_DEC + 512 + 2048;
struct HgA { float bl[16]; unsigned kk2[8]; };
__device__ __forceinline__ void hg1_stage_a(const HgRaw& r, float lbk, float* PART, int tid, HgA& a) {
  const int k = tid & 127, sg = tid >> 7; float run = 0.f; float kkf[16];
#pragma unroll
  for (int j = 0; j < 16; ++j) {
    const float f = lbk + (1.0f - lbk) * sigmoidf_(__uint_as_float(r.fv[j] << 16));
    run += __logf(f); a.bl[j] = run; kkf[j] = 1.0f - f;
  }
#pragma unroll
  for (int i = 0; i < 8; ++i) a.kk2[i] = cvt_pk_bf16(kkf[2 * i], kkf[2 * i + 1]);
  PART[sg * 128 + k] = run;
}
__device__ __forceinline__ float hg1_stage_b(const HgRaw& r, const HgA& a, unsigned char* shm, int kst_off, int vt_off, int part_off, int dec_off, int tid) {
  const int k = tid & 127, sg = tid >> 7;
  bf16_t* KST = (bf16_t*)(shm + kst_off); bf16_t* VT = (bf16_t*)(shm + vt_off); const float* PART = (const float*)(shm + part_off); float* DEC = (float*)(shm + dec_off);
  float off = 0.f;
#pragma unroll
  for (int g = 0; g < 4; ++g) off += (g < sg) ? PART[g * 128 + k] : 0.f;
  const float tot = PART[k] + PART[128 + k] + PART[256 + k] + PART[384 + k];
  float kst[16];
#pragma unroll
  for (int j = 0; j < 16; ++j) { const float kkj = (j & 1) ? __uint_as_float(a.kk2[j >> 1] & 0xffff0000u) : __uint_as_float(a.kk2[j >> 1] << 16); kst[j] = kkj * __expf(tot - (off + a.bl[j])); }
  u32x4 a0, a1, v0, v1;
#pragma unroll
  for (int i = 0; i < 4; ++i) { a0[i] = cvt_pk_bf16(kst[2 * i], kst[2 * i + 1]); a1[i] = cvt_pk_bf16(kst[8 + 2 * i], kst[8 + 2 * i + 1]);
    v0[i] = (r.fv[2 * i] >> 16) | (r.fv[2 * i + 1] & 0xffff0000u); v1[i] = (r.fv[8 + 2 * i] >> 16) | (r.fv[8 + 2 * i + 1] & 0xffff0000u); }
  *(u32x4*)(KST + k * 72 + sg * 16) = a0; *(u32x4*)(KST + k * 72 + sg * 16 + 8) = a1;
  *(u32x4*)(VT + k * 72 + sg * 16) = v0; *(u32x4*)(VT + k * 72 + sg * 16 + 8) = v1;
  if (sg == 0) DEC[k] = __expf(tot);
  return tot;
}
__device__ __forceinline__ void hg_state_update_at(f32x4 (&Sacc)[8], unsigned char* shm, int kst_off, int vt_off, int dec_off, int wv, int fr, int fq) {
  const bf16_t* KST = (const bf16_t*)(shm + kst_off); const bf16_t* VT = (const bf16_t*)(shm + vt_off); const float* DEC = (const float*)(shm + dec_off);
  float dc[4];
#pragma unroll
  for (int j = 0; j < 4; ++j) dc[j] = DEC[16 * wv + fq * 4 + j];
#pragma unroll
  for (int nt = 0; nt < 8; ++nt)
#pragma unroll
    for (int j = 0; j < 4; ++j) Sacc[nt][j] *= dc[j];
#pragma unroll
  for (int ks = 0; ks < 2; ++ks) {
    const bf16x8 a = *(const bf16x8*)(KST + (16 * wv + fr) * 72 + ks * 32 + fq * 8);
#pragma unroll
    for (int nt = 0; nt < 8; ++nt) {
      const bf16x8 b = *(const bf16x8*)(VT + (nt * 16 + fr) * 72 + ks * 32 + fq * 8);
      Sacc[nt] = __builtin_amdgcn_mfma_f32_16x16x32_bf16(a, b, Sacc[nt], 0, 0, 0);
    }
  }
}
__device__ __forceinline__ void hg1_unit(KP p, int u, unsigned char* shm, int tid) {
  const bool ctx = u >= 256; const int hd = ctx ? (u - 256) : (u >> 4); const int sc = ctx ? 0 : (u & 15); const int h = hd >> 1, d = hd & 1;
  const HgSrc s = hg_src(p, h, d, ctx);
  const int lane = tid & 63, wv = tid >> 6, fr = lane & 15, fq = lane >> 4;
  const float lbk = ((const float*)(p->ws + WS_LBS))[h * 128 + (tid & 127)];
  f32x4 Sacc[8];
#pragma unroll
  for (int nt = 0; nt < 8; ++nt) Sacc[nt] = (f32x4){0.f, 0.f, 0.f, 0.f};
  float dsum = 0.f;
  const int nch = ctx ? 4 : 16;
  HgRaw c0, c1; hg_load<false>(s, d, sc * 16, tid, c0); hg_load<false>(s, d, sc * 16 + 1, tid, c1);
#pragma unroll 1
  for (int c = 0; c < nch; c += 2) {
    HgRaw n0, n1;
    hg_load<false>(s, d, sc * 16 + (c + 2 < nch ? c + 2 : c), tid, n0); hg_load<false>(s, d, sc * 16 + (c + 2 < nch ? c + 3 : c + 1), tid, n1);
    HgA a0, a1;
    hg1_stage_a(c0, lbk, (float*)(shm + HG_PART), tid, a0); hg1_stage_a(c1, lbk, (float*)(shm + HG_PART2), tid, a1);
    lds_barrier();
    dsum += hg1_stage_b(c0, a0, shm, HG_KST, HG_VT, HG_PART, HG_DEC, tid);
    dsum += hg1_stage_b(c1, a1, shm, HG_KST2, HG_VT2, HG_PART2, HG_DEC2, tid);
    lds_barrier();
    hg_state_update_at(Sacc, shm, HG_KST, HG_VT, HG_DEC, wv, fr, fq);
    hg_state_update_at(Sacc, shm, HG_KST2, HG_VT2, HG_DEC2, wv, fr, fq);
    lds_barrier();
    c0 = n0; c1 = n1;
  }
  float* dst = ctx ? ((float*)(p->ws + WS_S0) + (size_t)hd * 16384) : ((float*)(p->ws + WS_SLOC) + (size_t)(hd * 16 + sc) * 16384);
#pragma unroll
  for (int nt = 0; nt < 8; ++nt)
#pragma unroll
    for (int j = 0; j < 4; ++j) dst[(16 * wv + fq * 4 + j) * 128 + nt * 16 + fr] = Sacc[nt][j];
  if (!ctx && tid < 128) ((float*)(p->ws + WS_DLOC))[(hd * 16 + sc) * 128 + tid] = __expf(dsum);
}
__device__ __forceinline__ void hg2_unit(KP p, int u, unsigned char* shm, int tid) {
  const int hd = u >> 4, sc = u & 15, h = hd >> 1, d = hd & 1;
  const HgSrc s = hg_src(p, h, d, false);
  const int lane = tid & 63, wv = tid >> 6, fr = lane & 15, fq = lane >> 4;
  const float lbk = ((const float*)(p->ws + WS_LBS))[h * 128 + (tid & 127)];
  f32x4 Sacc[8];
  {
    const float* S0 = (const float*)(p->ws + WS_S0) + (size_t)hd * 16384;
#pragma unroll
    for (int nt = 0; nt < 8; ++nt)
#pragma unroll
      for (int j = 0; j < 4; ++j) Sacc[nt][j] = S0[(16 * wv + fq * 4 + j) * 128 + nt * 16 + fr];
#pragma unroll 4
    for (int q = 0; q < sc; ++q) {
      const float* SL = (const float*)(p->ws + WS_SLOC) + (size_t)(hd * 16 + q) * 16384; const float* DL = (const float*)(p->ws + WS_DLOC) + (hd * 16 + q) * 128;
#pragma unroll
      for (int j = 0; j < 4; ++j) { const float dc = DL[16 * wv + fq * 4 + j];
#pragma unroll
        for (int nt = 0; nt < 8; ++nt) Sacc[nt][j] = dc * Sacc[nt][j] + SL[(16 * wv + fq * 4 + j) * 128 + nt * 16 + fr]; }
    }
  }
  hg_write_st(Sacc, shm, wv, fr, fq);
  __syncthreads();
  const bf16_t* QIN = (const bf16_t*)(shm + HG_QIN); const bf16_t* KIN = (const bf16_t*)(shm + HG_KIN); const bf16_t* VT = (const bf16_t*)(shm + HG_VT);
  bf16_t* AM = (bf16_t*)(shm + HG_AM); const bf16_t* ST = (const bf16_t*)(shm + HG_ST);
  bf16_t* OF = (bf16_t*)(p->ws + WS_OFB) + (size_t)d * SEQ * 1024 + h * 128;
  HgRaw cur; hg_load<true>(s, d, sc * 16, tid, cur);
#pragma unroll 1
  for (int c = 0; c < 16; ++c) {
    const int n = sc * 16 + c;
    HgRaw nxt; hg_load<true>(s, d, sc * 16 + (c + 1 < 16 ? c + 1 : c), tid, nxt);
    hg_prep<true>(cur, lbk, shm, tid);
#pragma unroll
    for (int i = 0; i < 2; ++i) {
      const int tt = wv + 8 * i; const int mt = tt >> 2, nt = tt & 3;
      f32x4 acc = (f32x4){0.f, 0.f, 0.f, 0.f};
      if (nt <= mt) {
#pragma unroll
        for (int ks = 0; ks < 4; ++ks) {
          const bf16x8 a = *(const bf16x8*)(QIN + (mt * 16 + fr) * 136 + ks * 32 + fq * 8);
          const bf16x8 b = *(const bf16x8*)(KIN + (nt * 16 + fr) * 136 + ks * 32 + fq * 8);
          acc = __builtin_amdgcn_mfma_f32_16x16x32_bf16(a, b, acc, 0, 0, 0);
        }
      }
#pragma unroll
      for (int j = 0; j < 4; ++j) { const int t = mt * 16 + fq * 4 + j, sl = nt * 16 + fr; AM[t * 72 + sl] = f2bf(sl <= t ? acc[j] : 0.f); }
    }
    lds_barrier();
    {
      const int mt = wv & 3, nb = (wv >> 2) * 4;
      f32x4 oacc[4];
#pragma unroll
      for (int x = 0; x < 4; ++x) oacc[x] = (f32x4){0.f, 0.f, 0.f, 0.f};
#pragma unroll
      for (int ks = 0; ks < 2; ++ks) {
        const bf16x8 a = *(const bf16x8*)(AM + (mt * 16 + fr) * 72 + ks * 32 + fq * 8);
#pragma unroll
        for (int x = 0; x < 4; ++x) { const bf16x8 b = *(const bf16x8*)(VT + ((nb + x) * 16 + fr) * 72 + ks * 32 + fq * 8); oacc[x] = __builtin_amdgcn_mfma_f32_16x16x32_bf16(a, b, oacc[x], 0, 0, 0); }
      }
#pragma unroll
      for (int ks = 0; ks < 4; ++ks) {
        const bf16x8 a = *(const bf16x8*)(QIN + (mt * 16 + fr) * 136 + ks * 32 + fq * 8);
#pragma unroll
        for (int x = 0; x < 4; ++x) { const bf16x8 b = *(const bf16x8*)(ST + ((nb + x) * 16 + fr) * 136 + ks * 32 + fq * 8); oacc[x] = __builtin_amdgcn_mfma_f32_16x16x32_bf16(a, b, oacc[x], 0, 0, 0); }
      }
#pragma unroll
      for (int j = 0; j < 4; ++j) {
        const int sp = n * 64 + mt * 16 + fq * 4 + j; const int t = d ? (SEQ - 1 - sp) : sp;
#pragma unroll
        for (int x = 0; x < 4; ++x) OF[(size_t)t * 1024 + (nb + x) * 16 + fr] = f2bf(oacc[x][j]);
      }
    }
    hg_state_update(Sacc, shm, wv, fr, fq);
    lds_barrier();
    hg_write_st(Sacc, shm, wv, fr, fq);
    cur = nxt;
  }
  __syncthreads();
}
__device__ __forceinline__ void phase_hgcomb(KP p, int tid) {
  const bf16_t* OF = (const bf16_t*)(p->ws + WS_OFB); const bf16_t* PG = (const bf16_t*)(p->ws + WS_PROJG); bf16_t* Y = (bf16_t*)(p->ws + WS_YMIX);
  const int lane = tid & 63, sub = lane >> 5, l32 = lane & 31; const int gw = blockIdx.x * 8 + (tid >> 6), nw = gridDim.x * 8;
#pragma unroll 4
  for (int it = gw; it < SEQ * 4; it += nw) {
    const int grp = it * 2 + sub; const int t = grp >> 3, h = grp & 7; const int c = h * 128 + l32 * 4;
    const u32x2 ar = *(const u32x2*)(OF + (size_t)t * 1024 + c), br = *(const u32x2*)(OF + (size_t)(SEQ + t) * 1024 + c);
    f32x4 o; o[0] = __uint_as_float(ar.x << 16) + __uint_as_float(br.x << 16); o[1] = __uint_as_float(ar.x & 0xffff0000u) + __uint_as_float(br.x & 0xffff0000u);
    o[2] = __uint_as_float(ar.y << 16) + __uint_as_float(br.y << 16); o[3] = __uint_as_float(ar.y & 0xffff0000u) + __uint_as_float(br.y & 0xffff0000u);
    float ss = o[0] * o[0] + o[1] * o[1] + o[2] * o[2] + o[3] * o[3];
#pragma unroll
    for (int m = 1; m < 32; m <<= 1) ss += shfl_xor_l(ss, m, lane);
    const float rstd = rsqrtf(ss * (1.0f / 128.0f) + 1e-6f);
    const f32x4 gn = *(const f32x4*)(p->in[23] + c);
    const u32x2 gr = *(const u32x2*)(PG + (size_t)t * 5120 + 4096 + c);
    float g[4] = {__uint_as_float(gr.x << 16), __uint_as_float(gr.x & 0xffff0000u), __uint_as_float(gr.y << 16), __uint_as_float(gr.y & 0xffff0000u)};
    float r[4];
#pragma unroll
    for (int k = 0; k < 4; ++k) r[k] = o[k] * rstd * gn[k] * g[k] * sigmoidf_(g[k]);
    u32x2 w; w.x = cvt_pk_bf16(r[0], r[1]); w.y = cvt_pk_bf16(r[2], r[3]);
    *(u32x2*)(Y + (size_t)t * DM + 1024 + c) = w;
  }
}

__device__ __forceinline__ void unpack8(const u32x4 r, float (&v)[8]) {
  v[0] = __uint_as_float(r.x << 16); v[1] = __uint_as_float(r.x & 0xffff0000u); v[2] = __uint_as_float(r.y << 16); v[3] = __uint_as_float(r.y & 0xffff0000u);
  v[4] = __uint_as_float(r.z << 16); v[5] = __uint_as_float(r.z & 0xffff0000u); v[6] = __uint_as_float(r.w << 16); v[7] = __uint_as_float(r.w & 0xffff0000u);
}
__device__ __forceinline__ float gelu_as(float v) {
  const float av = fabsf(v); const float t = __builtin_amdgcn_rcpf(av * 0.2316418882f + 1.0f);
  float q = t * 0.5307027145f + (-0.7265760135f); q = q * t + 0.7107068705f; q = q * t + (-0.142248368f); q = q * t + 0.127414796f; q = q * t;
  const float e = __builtin_amdgcn_exp2f((v * v) * (-0.72134752044f));
  const float m = v * (q * e);
  return v < 0.f ? m : v - m;
}
__device__ __forceinline__ void phase_conv(KP p, int l, int tid) {
  const bf16_t* A = (const bf16_t*)(p->ws + WS_ABUF); const bf16_t* U = (const bf16_t*)(p->ws + WS_UBUF); bf16_t* G = (bf16_t*)(p->ws + WS_GBUF);
  const float* cw = p->in[29] + (size_t)l * 9 * DFF; const float* cbias = p->in[30] + (size_t)l * DFF;
  constexpr int RB = 2, CB = 2;
  const int total = (256 / RB) * 4 * 1408;
#pragma unroll 1
  for (int it = blockIdx.x * NTH + tid; it < total; it += gridDim.x * NTH) {
    const int cc = it % 1408; const int rs = it / 1408; const int sgm = rs & 3, r0 = (rs >> 2) * RB; const int c0 = cc * 4;
    f32x4 w[9];
#pragma unroll
    for (int k = 0; k < 9; ++k) w[k] = *(const f32x4*)(cw + k * DFF + c0);
    const f32x4 bsv = *(const f32x4*)(cbias + c0);
    const bf16_t* rowp[RB + 2]; bool rv[RB + 2];
#pragma unroll
    for (int di = 0; di < RB + 2; ++di) { const int rr = r0 + di - 1; rv[di] = (rr >= 0) && (rr < 256); const int rc = rr < 0 ? 0 : (rr > 255 ? 255 : rr); rowp[di] = A + (size_t)(rc * 64) * DFF + c0; }
    float win[3][RB + 2][4];
    const int j0 = sgm * 16;
    {
      u32x2 ra[2][RB + 2];
#pragma unroll
      for (int s = 0; s < 2; ++s) { const int col = j0 - 1 + s; const int cl = col < 0 ? 0 : col;
#pragma unroll
        for (int di = 0; di < RB + 2; ++di) ra[s][di] = *(const u32x2*)(rowp[di] + (size_t)cl * DFF); }
#pragma unroll
      for (int s = 0; s < 2; ++s) { const int col = j0 - 1 + s;
#pragma unroll
        for (int di = 0; di < RB + 2; ++di) { const bool ok = rv[di] && (col >= 0); unpack4(ra[s][di], win[s][di]);
#pragma unroll
          for (int k = 0; k < 4; ++k) win[s][di][k] = ok ? win[s][di][k] : 0.f; } }
    }
#pragma unroll 1
    for (int jb = j0; jb < j0 + 16; jb += CB) {
      u32x2 an[CB][RB + 2], ur[CB][RB];
#pragma unroll
      for (int q = 0; q < CB; ++q) { const int col = jb + q + 1; const int cl = col > 63 ? 63 : col;
#pragma unroll
        for (int di = 0; di < RB + 2; ++di) an[q][di] = *(const u32x2*)(rowp[di] + (size_t)cl * DFF);
#pragma unroll
        for (int rr = 0; rr < RB; ++rr) ur[q][rr] = *(const u32x2*)(U + (size_t)((r0 + rr) * 64 + jb + q) * DFF + c0); }
      __builtin_amdgcn_sched_barrier(0);
#pragma unroll
      for (int q = 0; q < CB; ++q) {
        const int col = jb + q + 1;
#pragma unroll
        for (int di = 0; di < RB + 2; ++di) { const bool ok = rv[di] && (col < 64); unpack4(an[q][di], win[2][di]);
#pragma unroll
          for (int k = 0; k < 4; ++k) win[2][di][k] = ok ? win[2][di][k] : 0.f; }
#pragma unroll
        for (int rr = 0; rr < RB; ++rr) {
          float uv[4]; unpack4(ur[q][rr], uv);
          float o[4];
#pragma unroll
          for (int k = 0; k < 4; ++k) {
            float a = bsv[k];
#pragma unroll
            for (int di = 0; di < 3; ++di)
#pragma unroll
              for (int dj = 0; dj < 3; ++dj) a += win[dj][rr + di][k] * w[di * 3 + dj][k];
            o[k] = gelu_as(a) * uv[k];
          }
          u32x2 ow; ow.x = cvt_pk_bf16(o[0], o[1]); ow.y = cvt_pk_bf16(o[2], o[3]);
          *(u32x2*)(G + (size_t)((r0 + rr) * 64 + jb + q) * DFF + c0) = ow;
        }
#pragma unroll
        for (int di = 0; di < RB + 2; ++di)
#pragma unroll
          for (int k = 0; k < 4; ++k) { win[0][di][k] = win[1][di][k]; win[1][di][k] = win[2][di][k]; }
      }
    }
  }
}
template <int HW> __device__ __forceinline__ void pma_run(const bf16_t* HA, bf16_t* PM, int gi, int t0, int c0) {
  constexpr int R = 8 + 2 * HW - 1;
  u32x4 raw[R];
#pragma unroll
  for (int i = 0; i < R; ++i) { int q = t0 - HW + i; q = q < 0 ? 0 : (q > SEQ - 1 ? SEQ - 1 : q); raw[i] = *(const u32x4*)(HA + (size_t)q * DM + c0); }
  float s[8];
#pragma unroll
  for (int k = 0; k < 8; ++k) s[k] = 0.f;
#pragma unroll
  for (int i = 0; i < 2 * HW; ++i) { const int q = t0 - HW + i; const bool ok = (q >= 0) && (q < SEQ); float v[8]; unpack8(raw[i], v);
#pragma unroll
    for (int k = 0; k < 8; ++k) s[k] += ok ? v[k] : 0.f; }
#pragma unroll
  for (int o = 0; o < 8; ++o) {
    const int t = t0 + o;
    if (o > 0) {
      const int qa = t + HW - 1, qs = t - HW - 1;
      float va[8], vs[8]; unpack8(raw[2 * HW - 1 + o], va); unpack8(raw[o - 1], vs);
      const bool oka = qa < SEQ, oks = qs >= 0;
#pragma unroll
      for (int k = 0; k < 8; ++k) s[k] += (oka ? va[k] : 0.f) - (oks ? vs[k] : 0.f);
    }
    const int lo = max(t - HW, 0), hi = min(t + HW, SEQ);
    const float inv = 1.0f / (float)(hi - lo);
    float hv[8]; unpack8(raw[HW + o], hv);
    float r[8];
#pragma unroll
    for (int k = 0; k < 8; ++k) r[k] = s[k] * inv - hv[k];
    u32x4 ow; ow.x = cvt_pk_bf16(r[0], r[1]); ow.y = cvt_pk_bf16(r[2], r[3]); ow.z = cvt_pk_bf16(r[4], r[5]); ow.w = cvt_pk_bf16(r[6], r[7]);
    *(u32x4*)(PM + ((size_t)gi * SEQ + t) * 512 + (c0 & 511)) = ow;
  }
}
__device__ __forceinline__ void phase_pma(KP p, int tid) {
  const bf16_t* HA = (const bf16_t*)(p->ws + WS_HA); bf16_t* PM = (bf16_t*)(p->ws + WS_PMA);
  const int total = (SEQ / 8) * 256;
#pragma unroll 1
  for (int it = blockIdx.x * NTH + tid; it < total; it += gridDim.x * NTH) {
    const int t0 = (it >> 8) << 3, c0 = (it & 255) << 3; const int gi = c0 >> 9;
    if (gi == 0) pma_run<1>(HA, PM, 0, t0, c0); else if (gi == 1) pma_run<2>(HA, PM, 1, t0, c0); else if (gi == 2) pma_run<4>(HA, PM, 2, t0, c0); else pma_run<8>(HA, PM, 3, t0, c0);
  }
}

#define XB_TMO      128
#define XB_XCNT(j)  (256  + 64 * (j))
#define XB_XSUB(j)  (1280 + 64 * (j))
#define XB_XGEN(j)  (2304 + 64 * (j))
#define XB_TOP      3328
#define XB_TOPGEN   3392
#define XCD_BAR_WORDS 3456
#define XB_SPIN_CAP (1u << 18)
__device__ __forceinline__ unsigned xb_ld(unsigned* p)              { return __hip_atomic_load(p, __ATOMIC_RELAXED, __HIP_MEMORY_SCOPE_AGENT); }
__device__ __forceinline__ unsigned xb_add(unsigned* p, unsigned v) { return __hip_atomic_fetch_add(p, v, __ATOMIC_RELAXED, __HIP_MEMORY_SCOPE_AGENT); }
__device__ __forceinline__ unsigned xb_xcc_id() { return (unsigned)__builtin_amdgcn_s_getreg((3 << 11) | 20) & 0xFu; }
#define XB_SPIN(cond, bar) do { unsigned _sp = 0; while (cond) { __builtin_amdgcn_s_sleep(1); \
    if ((++_sp & 255u) == 0u) { if (xb_ld(&(bar)[XB_TMO])) break; if (_sp > XB_SPIN_CAP) { atomicAdd(&(bar)[XB_TMO], 1u); break; } } } } while (0)
struct XcdBarrier { unsigned* bar; unsigned x; volatile LAS unsigned* st; };
__device__ __forceinline__ XcdBarrier xcd_barrier_post(unsigned* bar, volatile LAS unsigned* st, bool leader) {
  XcdBarrier b; b.bar = bar; b.x = xb_xcc_id(); b.st = st;
  if (leader) (void)xb_add(&bar[XB_XCNT(b.x)], 1u);
  return b;
}
__device__ __forceinline__ void xcd_barrier_complete(unsigned* bar, unsigned x, unsigned& nloc, unsigned& nx) {
  const unsigned G = gridDim.x * gridDim.y * gridDim.z;
  unsigned sum, cnt, mine, sp = 0u;
  for (;;) {
    sum = 0u; cnt = 0u; mine = 0u;
#pragma unroll
    for (unsigned j = 0; j < 16; ++j) { const unsigned c = xb_ld(&bar[XB_XCNT(j)]); sum += c; cnt += (c > 0u) ? 1u : 0u; mine = (j == x) ? c : mine; }
    if (sum == G) break;
    __builtin_amdgcn_s_sleep(1);
    if ((++sp & 255u) == 0u) { if (xb_ld(&bar[XB_TMO])) break; if (sp > XB_SPIN_CAP) { atomicAdd(&bar[XB_TMO], 1u); break; } }
  }
  nloc = mine > 0u ? mine : 1u; nx = cnt > 0u ? cnt : 1u;
}
__device__ __forceinline__ void xcd_barrier(const XcdBarrier& b, bool leader) {
  asm volatile("s_waitcnt vmcnt(0)" ::: "memory");
  __syncthreads();
  if (leader) {
    unsigned* bar = b.bar;
    __builtin_amdgcn_s_waitcnt(0);
    unsigned nloc = b.st[0], nx = b.st[1];
    if (nloc == 0u) { xcd_barrier_complete(bar, b.x, nloc, nx); b.st[0] = nloc; b.st[1] = nx; }
    const unsigned old = xb_add(&bar[XB_XSUB(b.x)], 1u);
    const unsigned gen = old / nloc;
    if (old + 1u == (gen + 1u) * nloc) {
      __builtin_amdgcn_fence(__ATOMIC_RELEASE, "agent");
      asm volatile("s_waitcnt vmcnt(0)" ::: "memory");
      const unsigned og = xb_add(&bar[XB_TOP], 1u);
      const unsigned tg = og / nx;
      if (og + 1u == (tg + 1u) * nx) xb_add(&bar[XB_TOPGEN], 1u);
      else XB_SPIN(xb_ld(&bar[XB_TOPGEN]) == tg, bar);
      __builtin_amdgcn_fence(__ATOMIC_ACQUIRE, "agent");
      xb_add(&bar[XB_XGEN(b.x)], 1u);
      asm volatile("s_waitcnt vmcnt(0)" ::: "memory");
    } else {
      XB_SPIN(xb_ld(&bar[XB_XGEN(b.x)]) == gen, bar);
      __builtin_amdgcn_fence(__ATOMIC_ACQUIRE, "agent");
      asm volatile("s_waitcnt vmcnt(0)" ::: "memory");
    }
  }
  __syncthreads();
}

__global__ void __launch_bounds__(512, 2) mk_fwd(Params p) {
  extern __shared__ __attribute__((aligned(16))) unsigned char shm[];
  cg::grid_group grid = cg::this_grid();
  volatile LAS unsigned* xst = (volatile LAS unsigned*)(shm + LDS_MAIN);
  const int wave_id = __builtin_amdgcn_readfirstlane((int)(threadIdx.x >> 6));
  { const int t0 = fresh_tid(wave_id); if (t0 < 4) xst[t0] = 0u; }
  __syncthreads();
  (void)xcd_barrier_post((unsigned*)(p.ws + WS_BAR), xst, fresh_tid(wave_id) == 0);
#ifdef REPEAT_PH
  int rep = 0;
#endif
#pragma unroll 1
  for (int ph = p.ph_lo; ph < p.ph_hi; ++ph) {
    int tid = fresh_tid(wave_id);
    KP kp = (KP)__builtin_amdgcn_kernarg_segment_ptr(); asm volatile("" : "+s"(kp));
    switch (ph) {
      case 0: phase_prep(kp, shm, tid); break;
      case 1: case 7: case 11: case 14: case 18: phase_norm(kp, ph, shm, tid); break;
      case 2: case 6: case 8: case 10: case 13: case 15: case 17: phase_gemm(kp, ph, shm, tid); break;
      case 3:
#ifdef REP_HY
        for (int u = blockIdx.x; u < 512; u += gridDim.x) hyena_unit<REP_HY>(kp, u, (float2*)shm, wave_id);
#endif
        for (int u = blockIdx.x; u < 512; u += gridDim.x) hyena_unit<0>(kp, u, (float2*)shm, wave_id);
#ifdef REP_HG1
#pragma unroll 1
        for (int rr = 0; rr < 2; ++rr)
#endif
        for (int b = blockIdx.x; b < 272; b += gridDim.x) { const int u = b < 256 ? (((b & 7) << 5) | (b >> 3)) : b; hg1_unit(kp, u, shm, tid); __syncthreads(); }
        break;
      case 4:
        for (int b = blockIdx.x; b < 256; b += gridDim.x) hg2_unit(kp, ((b & 7) << 5) | (b >> 3), shm, tid);
        for (int u = blockIdx.x; u < 2048; u += gridDim.x) hy_headnorm_unit(kp, u, (float*)shm, tid);
        break;
      case 5: phase_hgcomb(kp, tid); break;
      case 9: case 16:
        phase_conv(kp, ph == 16, tid);
        if (ph == 9) tr_jobs(kp->in[28] + (size_t)DM * 2 * DFF, DM, 2 * DFF, (bf16_t*)(kp->ws + WS_WT_UP), (float*)shm, tid);
        break;
      case 12: phase_pma(kp, tid); break;
      default: break;
    }
    if (ph + 1 < p.ph_hi) {
      if (p.ph_hi > 1000) grid.sync();
      { XcdBarrier xb; xb.bar = (unsigned*)(kp->ws + WS_BAR); xb.x = xb_xcc_id(); xb.st = (volatile LAS unsigned*)(shm + LDS_MAIN); xcd_barrier(xb, fresh_tid(wave_id) == 0); }
    }
#ifdef REPEAT_PH
    if (ph == REPEAT_PH && rep == 0) { rep = 1; --ph; }
#endif
  }
}

extern "C" void kernel_launch(void* const* d_in, const int* in_sizes, int n_in, void* d_out, int out_size, void* d_ws, size_t ws_size, hipStream_t stream) {
  static int grid_blocks = 0;
  if (!grid_blocks) {
    int dev = 0, cus = 0, per_cu = 0;
    (void)hipGetDevice(&dev);
    (void)hipDeviceGetAttribute(&cus, hipDeviceAttributeMultiprocessorCount, dev);
    (void)hipFuncSetAttribute((const void*)mk_fwd, hipFuncAttributeMaxDynamicSharedMemorySize, LDS_BYTES);
    (void)hipOccupancyMaxActiveBlocksPerMultiprocessor(&per_cu, (const void*)mk_fwd, NTH, LDS_BYTES);
    if (per_cu < 1) per_cu = 1;
    grid_blocks = cus * per_cu;
    if (grid_blocks > 256) grid_blocks = 256;
    if (ws_size < WS_END) fprintf(stderr, "kernel_launch: workspace too small: %zu < %zu\n", ws_size, (size_t)WS_END);
  }
  Params p{};
  for (int i = 0; i < 33; ++i) p.in[i] = (const float*)d_in[i];
  p.out = (float*)d_out; p.ws = (unsigned char*)d_ws; p.ph_lo = 0; p.ph_hi = 19;
  (void)hipMemsetAsync((unsigned char*)d_ws + WS_BAR, 0, XCD_BAR_WORDS * sizeof(unsigned), stream);
  void* args[] = {&p};
  hipError_t e = hipLaunchCooperativeKernel((const void*)mk_fwd, dim3(grid_blocks), dim3(NTH), args, LDS_BYTES, stream);
  if (e != hipSuccess) fprintf(stderr, "cooperative launch failed: %s (grid %d)\n", hipGetErrorString(e), grid_blocks);
}
```

```cpp
#include <hip/hip_runtime.h>
#include <hip/hip_cooperative_groups.h>
#include <cstdio>
namespace cg = cooperative_groups;

#define LAS __attribute__((address_space(3)))
typedef unsigned short bf16_t;
typedef short bf16x8 __attribute__((ext_vector_type(8)));
typedef float f32x4 __attribute__((ext_vector_type(4)));
typedef unsigned u32x4 __attribute__((ext_vector_type(4)));
typedef unsigned u32x2 __attribute__((ext_vector_type(2)));

constexpr int SEQ = 16384, DM = 2048, DFF = 5632, CTXL = 256, NTH = 512;
constexpr int LDS_MAIN = 135168;
constexpr int LDS_BYTES = LDS_MAIN + 16;

constexpr size_t WS_WT_IN = 0;
constexpr size_t WS_WT_OUT = WS_WT_IN + 33554432;
constexpr size_t WS_WT_POOL = WS_WT_OUT + 8388608;
constexpr size_t WS_WT_UP = WS_WT_POOL + 2097152;
constexpr size_t WS_WT_DN = WS_WT_UP + 46137344;
constexpr size_t WS_MODV = WS_WT_DN + 23068672;
constexpr size_t WS_BAR = WS_MODV + 114688;
constexpr size_t WS_LBS = WS_MODV + 131072;
constexpr size_t WS_HA = WS_LBS + 4096;
constexpr size_t WS_BIG = WS_HA + 68157440;
constexpr size_t WS_PROJT = WS_BIG;
constexpr size_t WS_YMIX = WS_BIG;
constexpr size_t WS_PROJG = WS_BIG + 100663296;
constexpr size_t WS_FILT = WS_PROJG + 167772160;
constexpr size_t WS_OFB = WS_FILT;
constexpr size_t WS_Z2 = WS_FILT + 134217728;
constexpr size_t WS_H3PAD = WS_Z2 + 67108864;
constexpr size_t WS_W4PAD = WS_H3PAD + 8388608;
constexpr size_t WS_PCB = WS_W4PAD + 2097152;
constexpr size_t WS_SLOC = WS_PCB + 1572864;
constexpr size_t WS_DLOC = WS_SLOC + 16777216;
constexpr size_t WS_S0 = WS_DLOC + 131072;
constexpr size_t WS_KS = WS_S0 + 1048576;
constexpr size_t WS_YE = WS_KS + 33554432;
constexpr size_t WS_END = WS_YE + 33554432;
constexpr size_t WS_ABUF = WS_BIG;
constexpr size_t WS_UBUF = WS_BIG + 184549376;
constexpr size_t WS_GBUF = WS_UBUF + 184549376;
constexpr size_t WS_PMA = WS_BIG;

struct Params { const float* in[33]; float* out; unsigned char* ws; int ph_lo; int ph_hi; };
typedef const Params __attribute__((address_space(4)))* KP;

__device__ __forceinline__ unsigned cvt_pk_bf16(float lo, float hi) { unsigned r; asm volatile("v_cvt_pk_bf16_f32 %0, %1, %2" : "=v"(r) : "v"(lo), "v"(hi)); return r; }
__device__ __forceinline__ bf16_t f2bf(float f) { return (bf16_t)(cvt_pk_bf16(f, 0.f) & 0xffffu); }
__device__ __forceinline__ float bf2f(bf16_t b) { return __uint_as_float(((unsigned)b) << 16); }
__device__ __forceinline__ void unpack4(const u32x2 r, float (&v)[4]) {
  v[0] = __uint_as_float(r.x << 16); v[1] = __uint_as_float(r.x & 0xffff0000u); v[2] = __uint_as_float(r.y << 16); v[3] = __uint_as_float(r.y & 0xffff0000u);
}
__device__ __forceinline__ int lane_asm() { int l; asm volatile("v_mbcnt_lo_u32_b32 %0, -1, 0\n\tv_mbcnt_hi_u32_b32 %0, -1, %0" : "=v"(l)); return l; }
__device__ __forceinline__ int fresh_tid(int wave_id) { return wave_id * 64 + lane_asm(); }
__device__ __forceinline__ int lane_fresh() { return lane_asm(); }
__device__ __forceinline__ float shfl_xor_l(float v, int m, int lane) { return __int_as_float(__builtin_amdgcn_ds_bpermute((lane ^ m) << 2, __float_as_int(v))); }
__device__ __forceinline__ float shfl_idx(float v, int src) { return __int_as_float(__builtin_amdgcn_ds_bpermute(src << 2, __float_as_int(v))); }
__device__ __forceinline__ float wave_sum(float v) {
  const int lane = lane_fresh();
#pragma unroll
  for (int o = 1; o < 64; o <<= 1) v += shfl_xor_l(v, o, lane);
  return v;
}
__device__ __forceinline__ float sigmoidf_(float x) { return __builtin_amdgcn_rcpf(1.0f + __expf(-x)); }
__device__ __forceinline__ float hw_sin_rev(float r) { return __builtin_amdgcn_sinf(r); }
__device__ __forceinline__ float hw_cos_rev(float r) { return __builtin_amdgcn_cosf(r); }
__device__ __forceinline__ float2 cmul(float2 a, float2 b) { return make_float2(a.x * b.x - a.y * b.y, a.x * b.y + a.y * b.x); }
__device__ __forceinline__ float2 cadd(float2 a, float2 b) { return make_float2(a.x + b.x, a.y + b.y); }
__device__ __forceinline__ float2 csub(float2 a, float2 b) { return make_float2(a.x - b.x, a.y - b.y); }
__device__ __forceinline__ float2 ld_sc1_f2(const float2* p) {
  unsigned long long v = __hip_atomic_load((const unsigned long long*)p, __ATOMIC_RELAXED, __HIP_MEMORY_SCOPE_AGENT);
  return make_float2(__uint_as_float((unsigned)v), __uint_as_float((unsigned)(v >> 32)));
}
__device__ __forceinline__ float ld_sc1_f(const float* p) { return __uint_as_float(__hip_atomic_load((const unsigned*)p, __ATOMIC_RELAXED, __HIP_MEMORY_SCOPE_AGENT)); }

namespace pg8 {
constexpr int BM = 256, BK = 64, HALF = 128, HTB = HALF * BK * 2, NXCD = 8, WGM = 4;
__device__ __forceinline__ int lds_byte(int r, int c) { const int st = (r >> 4) * 2 + (c >> 5), rr = r & 15, cc = c & 31, ob = rr * 64 + cc * 2; return st * 1024 + (ob ^ (((ob >> 9) & 1) << 5)); }
__device__ __forceinline__ void stage_rc(int b, int& R, int& C) { const int st = b / 1024, sb = b % 1024, swz = sb ^ (((sb >> 9) & 1) << 5); R = (st >> 1) * 16 + swz / 64; C = (st & 1) * 32 + (swz % 64) / 2; }
__device__ __forceinline__ int perm32(int rho) { const int n = rho >> 4, i = rho & 15; return 8 * (i >> 2) + 4 * n + (i & 3); }
struct Unit { int pm, pn; };
struct Gemm { const bf16_t* A; const bf16_t* Bt; int M, N, K; };
struct StaticOrder {
  int nM, nN, nwg, G, c;
  __device__ __forceinline__ void init(int M, int N, int G_, int c_) { nM = M / BM; nN = N / BM; nwg = nM * nN; G = G_; c = c_; }
  __device__ __forceinline__ bool next(int i, Unit& u) const {
    const long L = (long)i * G + c; if (L >= nwg) return false;
    int wgid = (int)L; { const int q = nwg / NXCD, r = nwg % NXCD, xcd = wgid % NXCD, off = wgid / NXCD; wgid = (xcd < r ? xcd * (q + 1) : r * (q + 1) + (xcd - r) * q) + off; }
    const int nig = WGM * nN, gid = wgid / nig, fm = gid * WGM, gsz = (nM - fm) < WGM ? (nM - fm) : WGM;
    u.pm = fm + ((wgid % nig) % gsz); u.pn = (wgid % nig) / gsz; return true;
  }
};
struct Epi {
  int kind;
  int perm;
  bf16_t* O; int ldc; const float* bias; int split_cols; size_t split_stride;
  const float* src; float* dst; const float* gate; const float* scale; int coff;
  __device__ __forceinline__ void operator()(const f32x4 (&acc)[2][2][4][2], const Unit& u, int wr, int wc, int fr, int fq) const {
    if (kind == 0) {
      const int row0 = u.pm * BM + wr * 64 + fr; int colt = u.pn * BM; bf16_t* base = O;
      if (split_cols) { const int t = colt / split_cols; base += (size_t)t * split_stride; colt -= t * split_cols; }
      const int col0 = colt + wc * 32 + 8 * fq, bcol0 = u.pn * BM + wc * 32 + 8 * fq;
#pragma unroll
      for (int bj = 0; bj < 2; ++bj) {
        f32x4 b0 = (f32x4){0.f, 0.f, 0.f, 0.f}, b1 = b0;
        if (bias) { b0 = *(const f32x4*)(bias + bcol0 + bj * HALF); b1 = *(const f32x4*)(bias + bcol0 + bj * HALF + 4); }
#pragma unroll
        for (int ai = 0; ai < 2; ++ai)
#pragma unroll
          for (int m = 0; m < 4; ++m) {
            bf16_t* rowp = base + (size_t)(row0 + ai * HALF + m * 16) * ldc + col0 + bj * HALF;
            const f32x4 v0 = acc[ai][bj][m][0] + b0, v1 = acc[ai][bj][m][1] + b1;
            u32x4 o; o.x = cvt_pk_bf16(v0[0], v0[1]); o.y = cvt_pk_bf16(v0[2], v0[3]); o.z = cvt_pk_bf16(v1[0], v1[1]); o.w = cvt_pk_bf16(v1[2], v1[3]);
            *(u32x4*)rowp = o;
          }
      }
    } else if (kind == 1) {
      const int row0 = u.pm * BM + wr * 64 + fr; const int col0 = u.pn * BM + wc * 32 + 8 * fq;
      const float md0 = -3.0701134573253944f, md1 = -15.350567286626973f;
#pragma unroll
      for (int ai = 0; ai < 2; ++ai)
#pragma unroll
        for (int m = 0; m < 4; ++m) {
          const int row = row0 + ai * HALF + m * 16; const int ch = row & 1023;
          const float delta = fabsf(md0 + (float)ch * ((md1 - md0) / 1023.0f));
          const float kf = -delta * (1.0f / 16383.0f);
          float ee[8];
#pragma unroll
          for (int e = 0; e < 8; ++e) ee[e] = __expf(kf * (float)e);
#pragma unroll
          for (int bj = 0; bj < 2; ++bj) {
            const int cb = col0 + bj * HALF;
            const float eb = __expf(kf * (float)cb);
            const f32x4 v0 = acc[ai][bj][m][0] * eb, v1 = acc[ai][bj][m][1] * eb;
            u32x4 o;
            o.x = cvt_pk_bf16(v0[0] * ee[0], v0[1] * ee[1]);
            o.y = cvt_pk_bf16(v0[2] * ee[2], v0[3] * ee[3]);
            o.z = cvt_pk_bf16(v1[0] * ee[4], v1[1] * ee[5]);
            o.w = cvt_pk_bf16(v1[2] * ee[6], v1[3] * ee[7]);
            *(u32x4*)(O + (size_t)row * ldc + cb) = o;
          }
        }
    } else {
      const int row0 = u.pm * BM + wr * 64 + fr, col0 = coff + u.pn * BM + wc * 32 + 4 * fq;
#pragma unroll
      for (int bj = 0; bj < 2; ++bj)
#pragma unroll
        for (int n = 0; n < 2; ++n) {
          const int c = col0 + bj * HALF + n * 16;
          f32x4 mul = *(const f32x4*)(gate + c);
          f32x4 add = (f32x4){0.f, 0.f, 0.f, 0.f};
          if (scale) mul = mul * *(const f32x4*)(scale + c);
          if (bias) add = *(const f32x4*)(bias + c) * mul;
#pragma unroll
          for (int ai = 0; ai < 2; ++ai)
#pragma unroll
            for (int m = 0; m < 4; ++m) {
              const size_t off = (size_t)(row0 + ai * HALF + m * 16) * DM + c;
              const f32x4 s = *(const f32x4*)(src + off);
              *(f32x4*)(dst + off) = acc[ai][bj][m][n] * mul + add + s;
            }
        }
    }
  }
};

__device__ __forceinline__ void gemm_phase(LAS unsigned char* lds, const Gemm g, const StaticOrder& S, const Epi& E, const int tid) {
  const int wid = __builtin_amdgcn_readfirstlane(tid >> 6), lane = tid & 63, wr = wid >> 2, wc = wid & 3, fr = lane & 15, fq = lane >> 4;
  const int K = g.K, nt = K / BK;
  unsigned voffA[2], voffB[2];
#pragma unroll
  for (int i = 0; i < 2; ++i) { int R, C; stage_rc(tid * 16 + i * 8192, R, C); const int Rb = E.perm ? ((R & ~31) + perm32(R & 31)) : R;
    voffA[i] = (unsigned)(R * K + C) * 2u; voffB[i] = (unsigned)(Rb * K + C) * 2u; }
  const size_t kstep = (size_t)(BK * 2);
  const size_t hstep = (size_t)HALF * K * 2;
  const size_t tstep = 2 * hstep;
  const unsigned ldsw = (unsigned)wid * 1024u;
  const int aoff = lds_byte(wr * 64 + fr, fq * 8), boff = lds_byte(wc * 32 + fr, fq * 8);
#define PG8_SA(b, h) (((b) * 2 + (h)) * HTB)
#define PG8_SB(b, h) ((4 + (b) * 2 + (h)) * HTB)
#define PG8_STAGE(bufoff, gbase, voff) do { _Pragma("unroll") for (int _i = 0; _i < 2; ++_i) \
    __builtin_amdgcn_global_load_lds((const unsigned*)((const char*)(gbase) + (voff)[_i]), (LAS unsigned*)(lds + (bufoff) + ldsw + _i * 8192), 16, 0, 0); } while (0)
#define PG8_LDA(dst, b, h) do { _Pragma("unroll") for (int m = 0; m < 4; ++m) _Pragma("unroll") for (int k = 0; k < 2; ++k) dst[m][k] = *(const LAS bf16x8*)(lds + PG8_SA(b, h) + aoff + m * 2048 + k * 1024); } while (0)
#define PG8_LDB(dst, b, h) do { _Pragma("unroll") for (int n = 0; n < 2; ++n) _Pragma("unroll") for (int k = 0; k < 2; ++k) dst[n][k] = *(const LAS bf16x8*)(lds + PG8_SB(b, h) + boff + n * 2048 + k * 1024); } while (0)
#define PG8_MMA(ai, bj, At, Bt) do { __builtin_amdgcn_s_setprio(1); _Pragma("unroll") for (int m = 0; m < 4; ++m) _Pragma("unroll") for (int n = 0; n < 2; ++n) _Pragma("unroll") for (int k = 0; k < 2; ++k) \
    acc[ai][bj][m][n] = __builtin_amdgcn_mfma_f32_16x16x32_bf16(Bt[n][k], At[m][k], acc[ai][bj][m][n], 0, 0, 0); __builtin_amdgcn_s_setprio(0); } while (0)
#define PG8_WAIT_V(n) asm volatile("s_waitcnt vmcnt(" #n ")" ::: "memory")
#define PG8_WAIT_L(n) asm volatile("s_waitcnt lgkmcnt(" #n ")" ::: "memory")
#define PG8_BAR __builtin_amdgcn_s_barrier()
#define PG8_SCHED __builtin_amdgcn_sched_barrier(0)
  Unit cur, nxt; int ui = 0;
  if (!S.next(0, cur)) return;
  f32x4 acc[2][2][4][2];
#pragma unroll
  for (int a = 0; a < 2; ++a)
#pragma unroll
    for (int b = 0; b < 2; ++b)
#pragma unroll
      for (int m = 0; m < 4; ++m)
#pragma unroll
        for (int n = 0; n < 2; ++n) acc[a][b][m][n] = (f32x4){0.f, 0.f, 0.f, 0.f};
  bf16x8 At[4][2], B0[2][2], B1[2][2];
  const char* cA = (const char*)g.A + (size_t)cur.pm * tstep; const char* cB = (const char*)g.Bt + (size_t)cur.pn * tstep;
  PG8_STAGE(PG8_SB(0, 0), cB, voffB); PG8_STAGE(PG8_SA(0, 0), cA, voffA); PG8_STAGE(PG8_SB(0, 1), cB + hstep, voffB); PG8_STAGE(PG8_SA(0, 1), cA + hstep, voffA);
  if (wr == 1) PG8_BAR;
  PG8_WAIT_V(4); PG8_BAR;
  PG8_STAGE(PG8_SB(1, 0), cB + kstep, voffB); PG8_STAGE(PG8_SA(1, 0), cA + kstep, voffA); PG8_STAGE(PG8_SB(1, 1), cB + hstep + kstep, voffB);
  PG8_WAIT_V(6); PG8_BAR;
  for (;;) {
    const bool has_next = S.next(ui + 1, nxt);
    const char* nA = has_next ? (const char*)g.A + (size_t)nxt.pm * tstep : cA; const char* nB = has_next ? (const char*)g.Bt + (size_t)nxt.pn * tstep : cB;
    for (int t = 0; t < nt; t += 2) {
      const bool last = (t == nt - 2);
      const char* a1 = cA + (size_t)(t + 1) * kstep;
      const char* a2 = last ? nA : cA + (size_t)(t + 2) * kstep; const char* b2 = last ? nB : cB + (size_t)(t + 2) * kstep;
      const char* a3 = a2 + kstep; const char* b3 = b2 + kstep;
      PG8_LDB(B0, 0, 0); PG8_SCHED; PG8_LDA(At, 0, 0); PG8_STAGE(PG8_SA(1, 1), a1 + hstep, voffA);
      PG8_WAIT_L(8); PG8_BAR; PG8_WAIT_L(0); PG8_MMA(0, 0, At, B0); PG8_BAR; PG8_SCHED;
      PG8_LDB(B1, 0, 1); PG8_STAGE(PG8_SB(0, 0), b2, voffB);
      PG8_BAR; PG8_WAIT_L(0); PG8_MMA(0, 1, At, B1); PG8_BAR;
      PG8_LDA(At, 0, 1); PG8_STAGE(PG8_SA(0, 0), a2, voffA);
      PG8_BAR; PG8_WAIT_L(0); PG8_MMA(1, 0, At, B0); PG8_BAR; PG8_SCHED;
      PG8_STAGE(PG8_SB(0, 1), b2 + hstep, voffB);
      PG8_WAIT_V(6); PG8_BAR; PG8_MMA(1, 1, At, B1); PG8_BAR;
      PG8_LDB(B0, 1, 0); PG8_SCHED; PG8_LDA(At, 1, 0); PG8_STAGE(PG8_SA(0, 1), a2 + hstep, voffA);
      PG8_WAIT_L(8); PG8_BAR; PG8_WAIT_L(0); PG8_MMA(0, 0, At, B0); PG8_BAR; PG8_SCHED;
      PG8_LDB(B1, 1, 1); PG8_STAGE(PG8_SB(1, 0), b3, voffB);
      PG8_BAR; PG8_WAIT_L(0); PG8_MMA(0, 1, At, B1); PG8_BAR;
      PG8_LDA(At, 1, 1); PG8_STAGE(PG8_SA(1, 0), a3, voffA);
      PG8_BAR; PG8_WAIT_L(0); PG8_MMA(1, 0, At, B0); PG8_BAR; PG8_SCHED;
      PG8_STAGE(PG8_SB(1, 1), b3 + hstep, voffB);
      PG8_WAIT_V(6); PG8_BAR; PG8_MMA(1, 1, At, B1); PG8_BAR;
    }
    E(acc, cur, wr, wc, fr, fq);
    if (!has_next) break;
#pragma unroll
    for (int a = 0; a < 2; ++a)
#pragma unroll
      for (int b = 0; b < 2; ++b)
#pragma unroll
        for (int m = 0; m < 4; ++m)
#pragma unroll
          for (int n = 0; n < 2; ++n) acc[a][b][m][n] = (f32x4){0.f, 0.f, 0.f, 0.f};
    cur = nxt; cA = nA; cB = nB; ++ui;
  }
  PG8_WAIT_V(0);
  if (wr == 0) PG8_BAR;
  PG8_BAR;
#undef PG8_SA
#undef PG8_SB
#undef PG8_STAGE
#undef PG8_LDA
#undef PG8_LDB
#undef PG8_MMA
#undef PG8_WAIT_V
#undef PG8_WAIT_L
#undef PG8_BAR
#undef PG8_SCHED
}
}

__device__ __forceinline__ bool gemm_job(KP p, int ph, int idx, pg8::Gemm& g, pg8::Epi& e) {
  unsigned char* ws = p->ws;
  e.kind = 0; e.perm = 1; e.O = nullptr; e.ldc = 0; e.bias = nullptr; e.split_cols = 0; e.split_stride = 0;
  e.src = nullptr; e.dst = nullptr; e.gate = nullptr; e.scale = nullptr; e.coff = 0;
  const float* modv = (const float*)(ws + WS_MODV);
  const bf16_t* HA = (const bf16_t*)(ws + WS_HA);
  if (ph == 2) {
    const bf16_t* WTI = (const bf16_t*)(ws + WS_WT_IN);
    if (idx == 0) { g.A = WTI; g.Bt = HA; g.M = 3072; g.N = SEQ; g.K = DM; e.O = (bf16_t*)(ws + WS_PROJT); e.ldc = SEQ; return true; }
    if (idx == 1) { g.A = HA; g.Bt = WTI + (size_t)3072 * DM; g.M = SEQ; g.N = 5120; g.K = DM; e.O = (bf16_t*)(ws + WS_PROJG); e.ldc = 5120; e.bias = p->in[9] + 3072; return true; }
    if (idx == 2) { g.A = HA + (size_t)SEQ * DM; g.Bt = WTI + (size_t)4096 * DM; g.M = CTXL; g.N = 3072; g.K = DM; e.O = (bf16_t*)(ws + WS_PCB); e.ldc = 3072; e.bias = p->in[9] + 4096; return true; }
    if (idx == 3) { g.A = (const bf16_t*)(ws + WS_W4PAD); g.Bt = (const bf16_t*)(ws + WS_H3PAD); g.M = 4096; g.N = SEQ; g.K = 256; e.kind = 1; e.O = (bf16_t*)(ws + WS_FILT); e.ldc = SEQ; return true; }
    return false;
  }
  if (ph == 6) {
    if (idx) return false;
    g.A = (const bf16_t*)(ws + WS_YMIX); g.Bt = (const bf16_t*)(ws + WS_WT_OUT); g.M = SEQ; g.N = DM; g.K = DM;
    e.kind = 2; e.perm = 0; e.src = p->in[0]; e.dst = p->out; e.gate = modv + 2 * DM; return true;
  }
  if (ph == 8 || ph == 15) {
    if (idx) return false;
    g.A = HA; g.Bt = (const bf16_t*)(ws + WS_WT_UP); g.M = SEQ; g.N = 2 * DFF; g.K = DM;
    e.O = (bf16_t*)(ws + WS_ABUF); e.ldc = DFF; e.split_cols = DFF; e.split_stride = (size_t)SEQ * DFF; return true;
  }
  if (ph == 10 || ph == 17) {
    if (idx) return false;
    const int l = (ph == 17);
    g.A = (const bf16_t*)(ws + WS_GBUF); g.Bt = (const bf16_t*)(ws + WS_WT_DN); g.M = SEQ; g.N = DM; g.K = DFF;
    e.kind = 2; e.perm = 0; e.src = p->out; e.dst = p->out; e.gate = modv + l * 12288 + 5 * DM; return true;
  }
  if (ph == 13) {
    if (idx >= 4) return false;
    g.A = (const bf16_t*)(ws + WS_PMA) + (size_t)idx * SEQ * 512; g.Bt = (const bf16_t*)(ws + WS_WT_POOL) + (size_t)idx * 512 * 512; g.M = SEQ; g.N = 512; g.K = 512;
    e.kind = 2; e.perm = 0; e.src = p->out; e.dst = p->out; e.gate = modv + 12288 + 2 * DM; e.bias = p->in[26]; e.scale = p->in[27]; e.coff = idx * 512; return true;
  }
  return false;
}

__device__ __forceinline__ void phase_gemm(KP p, int ph, unsigned char* shm, int tid) {
#pragma unroll 1
  for (int it = 0; it < 4; ++it) {
    pg8::Gemm g; pg8::Epi e;
    int idx = it, Ge = (int)gridDim.x, ce = (int)blockIdx.x;
    if (ph == 13) {
      const int G2 = (int)gridDim.x >> 1, hf = (int)blockIdx.x >= G2 ? 1 : 0;
      if (it >= 2) break;
      idx = 2 * it + hf; Ge = G2; ce = (int)blockIdx.x - hf * G2;
    }
    if (ph == 2 && it == 3 && (int)gridDim.x > 24) {
      if ((int)blockIdx.x < 12) break;
      Ge = (int)gridDim.x - 12; ce = (int)blockIdx.x - 12;
    }
    if (!gemm_job(p, ph, idx, g, e)) break;
    pg8::StaticOrder S; S.init(g.M, g.N, Ge, ce);
    pg8::gemm_phase((LAS unsigned char*)shm, g, S, e, tid);
    __syncthreads();
  }
}

__device__ __forceinline__ void tr_item(const float* __restrict__ W, int K, int N, bf16_t* __restrict__ WT, int item, float* scr, int lane) {
  const int nblk = N >> 5; const int kb = item / nblk, nb = item - kb * nblk; const int k0 = kb << 6, n0 = nb << 5;
  float v[32];
#pragma unroll
  for (int i = 0; i < 32; ++i) v[i] = W[(size_t)(k0 + 2 * i + (lane >> 5)) * N + n0 + (lane & 31)];
#pragma unroll
  for (int i = 0; i < 32; ++i) scr[(2 * i + (lane >> 5)) * 33 + (lane & 31)] = v[i];
  __builtin_amdgcn_fence(__ATOMIC_RELEASE, "wavefront"); __builtin_amdgcn_wave_barrier(); __builtin_amdgcn_fence(__ATOMIC_ACQUIRE, "wavefront");
  const int c = lane & 7;
#pragma unroll
  for (int jj = 0; jj < 4; ++jj) { const int n = (lane >> 3) + 8 * jj; const float* s = scr + (8 * c) * 33 + n;
    u32x4 o; o.x = cvt_pk_bf16(s[0], s[33]); o.y = cvt_pk_bf16(s[2 * 33], s[3 * 33]); o.z = cvt_pk_bf16(s[4 * 33], s[5 * 33]); o.w = cvt_pk_bf16(s[6 * 33], s[7 * 33]);
    *(u32x4*)(WT + (size_t)(n0 + n) * K + k0 + 8 * c) = o; }
  __builtin_amdgcn_fence(__ATOMIC_RELEASE, "wavefront"); __builtin_amdgcn_wave_barrier(); __builtin_amdgcn_fence(__ATOMIC_ACQUIRE, "wavefront");
}
__device__ __forceinline__ void tr_jobs_part(const float* W, int K, int N, bf16_t* WT, float* sm, int tid, int rank, int nblk) {
  const int cnt = (K >> 6) * (N >> 5); const int lane = tid & 63, wv = tid >> 6;
  float* scr = sm + wv * (64 * 33);
#pragma unroll 1
  for (int t = rank * 8 + wv; t < cnt; t += nblk * 8) tr_item(W, K, N, WT, t, scr, lane);
  __syncthreads();
}
__device__ __forceinline__ void tr_jobs(const float* W, int K, int N, bf16_t* WT, float* sm, int tid) { tr_jobs_part(W, K, N, WT, sm, tid, (int)blockIdx.x, (int)gridDim.x); }

__device__ __forceinline__ void adaln_unit(KP p, int u, float* sm, int tid) {
  const int l = u >> 7, j0 = (u & 127) * 96;
  const float* c = p->in[1]; const float* cc = p->in[3];
  for (int k = tid; k < DM; k += NTH) { const float a = c[k]; sm[k] = a / (1.0f + expf(-a)); const float b = cc[k]; sm[DM + k] = b / (1.0f + expf(-b)); }
  __syncthreads();
  const int c4 = tid % 24, rg = tid / 24;
  float* red = sm + 2 * DM;
  if (rg < 21) {
    f32x4 a1 = (f32x4){0.f, 0.f, 0.f, 0.f}, a2 = a1;
    const float* W = p->in[6] + (size_t)l * DM * 12288 + j0 + 4 * c4;
    for (int k = rg; k < DM; k += 21) { const f32x4 w = *(const f32x4*)(W + (size_t)k * 12288); a1 += sm[k] * w; a2 += sm[DM + k] * w; }
    float* d1 = red + (rg * 2 + 0) * 96 + 4 * c4; d1[0] = a1[0]; d1[1] = a1[1]; d1[2] = a1[2]; d1[3] = a1[3];
    float* d2 = red + (rg * 2 + 1) * 96 + 4 * c4; d2[0] = a2[0]; d2[1] = a2[1]; d2[2] = a2[2]; d2[3] = a2[3];
  }
  __syncthreads();
  if (tid < 192) {
    const int which = tid / 96, j = tid % 96; float s = 0.f;
    for (int r = 0; r < 21; ++r) s += red[(r * 2 + which) * 96 + j];
    s += p->in[7][l * 12288 + j0 + j];
    float* modv = (float*)(p->ws + WS_MODV);
    if (which == 0) modv[l * 12288 + j0 + j] = s; else if (l == 0 && j0 + j < 4096) modv[24576 + j0 + j] = s;
  }
  __syncthreads();
}

__device__ __forceinline__ void hymlp_unit(KP p, int u, int tid) {
  const int lane = tid & 63, wv = tid >> 6; const int t = u * 8 + wv;
  const float tl = (float)t / 16383.0f;
  float z = 0.f;
  if (lane == 0) z = tl;
  else if (lane < 33) {
    const int bi = (lane - 1) & 15;
    const float f = 1e-4f + (float)bi * ((15.0f - 1e-4f) / 15.0f);
    float rev = f * (float)t * (1.0f / 16384.0f); rev = rev - floorf(rev);
    z = (lane < 17) ? hw_cos_rev(rev) : -hw_sin_rev(rev);
  }
  const float* w1 = p->in[12]; const float* b1 = p->in[13]; const float* w2 = p->in[14]; const float* b2 = p->in[15];
  const float* w3 = p->in[16]; const float* b3 = p->in[17]; const float* fr = p->in[18];
  float a = b1[lane];
  for (int i = 0; i < 33; ++i) a += shfl_idx(z, i) * w1[i * 64 + lane];
  float r1 = fr[lane] * a * 0.15915494309189535f; r1 -= floorf(r1);
  float h = hw_sin_rev(r1);
  a = b2[lane];
  for (int i = 0; i < 64; ++i) a += shfl_idx(h, i) * w2[i * 64 + lane];
  r1 = fr[64 + lane] * a * 0.15915494309189535f; r1 -= floorf(r1);
  h = hw_sin_rev(r1);
  a = b3[lane];
  for (int i = 0; i < 64; ++i) a += shfl_idx(h, i) * w3[i * 64 + lane];
  r1 = fr[128 + lane] * a * 0.15915494309189535f; r1 -= floorf(r1);
  h = hw_sin_rev(r1);
  bf16_t* H3 = (bf16_t*)(p->ws + WS_H3PAD) + (size_t)t * 256;
  const bf16_t hi = f2bf(h); const bf16_t lo = f2bf(h - bf2f(hi));
  H3[lane] = hi; H3[64 + lane] = hi; H3[128 + lane] = lo; H3[192 + lane] = 0;
}

__device__ __forceinline__ void phase_prep(KP p, unsigned char* shm, int tid) {
  float* sm = (float*)shm;
  unsigned char* ws = p->ws;
  for (int u = blockIdx.x; u < 256; u += gridDim.x) adaln_unit(p, u, sm, tid);
  for (int u = blockIdx.x; u < 2048; u += gridDim.x) hymlp_unit(p, u, tid);
  for (int i = blockIdx.x * NTH + tid; i < 4096 * 64; i += gridDim.x * NTH) {
    const int k = i >> 12, n = i & 4095; const float w = p->in[19][i];
    const bf16_t hi = f2bf(w), lo = f2bf(w - bf2f(hi));
    bf16_t* d = (bf16_t*)(ws + WS_W4PAD) + (size_t)n * 256 + k; d[0] = hi; d[64] = lo; d[128] = hi; d[192] = 0;
  }
  if (blockIdx.x == 0) for (int c = tid; c < 1024; c += NTH) { const float a0 = p->in[22][c], a1 = p->in[22][1024 + c]; ((float*)(ws + WS_LBS))[c] = 1.0f / (1.0f + expf(a1 - a0)); }
  tr_jobs(p->in[8], DM, 8192, (bf16_t*)(ws + WS_WT_IN), sm, tid);
  tr_jobs(p->in[24], DM, DM, (bf16_t*)(ws + WS_WT_OUT), sm, tid);
  for (int gi = 0; gi < 4; ++gi) tr_jobs(p->in[25] + (size_t)gi * 512 * 512, 512, 512, (bf16_t*)(ws + WS_WT_POOL) + (size_t)gi * 512 * 512, sm, tid);
  tr_jobs(p->in[31], DFF, DM, (bf16_t*)(ws + WS_WT_DN), sm, tid);
}

__device__ __forceinline__ void norm_rows(const float* src, int nrows, const float* gam, const float* sc, const float* sh, bf16_t* dst, int tid) {
  const int lane = tid & 63; const int gw = blockIdx.x * 8 + (tid >> 6), nw = gridDim.x * 8;
#pragma unroll 1
  for (int r0 = gw; r0 < nrows; r0 += 4 * nw) {
    f32x4 v[4][8]; float ss[4]; int rr[4]; bool ok[4];
#pragma unroll
    for (int q = 0; q < 4; ++q) { const int r = r0 + q * nw; ok[q] = r < nrows; rr[q] = ok[q] ? r : r0; }
#pragma unroll
    for (int q = 0; q < 4; ++q) { const f32x4* xr = (const f32x4*)(src + (size_t)rr[q] * DM) + lane;
#pragma unroll
      for (int j = 0; j < 8; ++j) v[q][j] = xr[64 * j]; }
#pragma unroll
    for (int q = 0; q < 4; ++q) { float s = 0.f;
#pragma unroll
      for (int j = 0; j < 8; ++j) s += v[q][j][0] * v[q][j][0] + v[q][j][1] * v[q][j][1] + v[q][j][2] * v[q][j][2] + v[q][j][3] * v[q][j][3];
      ss[q] = rsqrtf(wave_sum(s) * (1.0f / DM) + 1e-6f); }
#pragma unroll
    for (int j = 0; j < 8; ++j) {
      const int c = 4 * (lane + 64 * j);
      const f32x4 mul = *(const f32x4*)(gam + c) * (1.0f + *(const f32x4*)(sc + c)); const f32x4 add = *(const f32x4*)(sh + c);
#pragma unroll
      for (int q = 0; q < 4; ++q) if (ok[q]) {
        const f32x4 h = v[q][j] * ss[q] * mul + add; u32x2 w; w.x = cvt_pk_bf16(h[0], h[1]); w.y = cvt_pk_bf16(h[2], h[3]);
        ((u32x2*)(dst + (size_t)rr[q] * DM) + lane)[64 * j] = w;
      }
    }
  }
}
__device__ __forceinline__ void final_norm(float* x, const float* gam, int tid) {
  const int lane = tid & 63; const int gw = blockIdx.x * 8 + (tid >> 6), nw = gridDim.x * 8;
  for (int r = gw; r < SEQ; r += nw) {
    f32x4* xr = (f32x4*)(x + (size_t)r * DM) + lane;
    f32x4 v[8]; float ss = 0.f;
#pragma unroll
    for (int j = 0; j < 8; ++j) { v[j] = xr[64 * j]; ss += v[j][0] * v[j][0] + v[j][1] * v[j][1] + v[j][2] * v[j][2] + v[j][3] * v[j][3]; }
    const float rstd = rsqrtf(wave_sum(ss) * (1.0f / DM) + 1e-6f);
#pragma unroll
    for (int j = 0; j < 8; ++j) xr[64 * j] = v[j] * rstd * *(const f32x4*)(gam + 4 * (lane + 64 * j));
  }
}
__device__ __forceinline__ void phase_norm(KP p, int ph, unsigned char* shm, int tid) {
  unsigned char* ws = p->ws; const float* modv = (const float*)(ws + WS_MODV); bf16_t* HA = (bf16_t*)(ws + WS_HA);
  if (ph == 18) { final_norm(p->out, p->in[32], tid); return; }
  const int l = (ph >= 11), ffn = (ph == 7 || ph == 14);
  const float* gam = (ffn ? p->in[5] : p->in[4]) + l * DM;
  const float* sh = modv + l * 12288 + (ffn ? 3 : 0) * DM; const float* sc = sh + DM;
  norm_rows(ph == 1 ? p->in[0] : p->out, SEQ, gam, sc, sh, HA, tid);
  if (ph == 1) norm_rows(p->in[2], CTXL, gam, modv + 24576 + DM, modv + 24576, HA + (size_t)SEQ * DM, tid);
  if (ph == 11) tr_jobs(p->in[31] + (size_t)DFF * DM, DFF, DM, (bf16_t*)(ws + WS_WT_DN), (float*)shm, tid);
}

__device__ __forceinline__ constexpr int FP(int n) { return n + (n >> 5); }
__device__ __forceinline__ constexpr float tw32c(int k) {
  switch (k & 15) { case 0: return 1.0f; case 1: return 0.98078528040323044913f; case 2: return 0.92387953251128675613f; case 3: return 0.83146961230254523708f;
    case 4: return 0.70710678118654752440f; case 5: return 0.55557023301960222474f; case 6: return 0.38268343236508977173f; case 7: return 0.19509032201612826785f;
    case 8: return 0.0f; case 9: return -0.19509032201612826785f; case 10: return -0.38268343236508977173f; case 11: return -0.55557023301960222474f;
    case 12: return -0.70710678118654752440f; case 13: return -0.83146961230254523708f; case 14: return -0.92387953251128675613f; default: return -0.98078528040323044913f; }
}
__device__ __forceinline__ constexpr float tw32s(int k) { return tw32c((k + 24) & 31 & 15) * ((((k + 24) & 31) >= 16) ? -1.0f : 1.0f); }
__device__ __forceinline__ constexpr int brev_n(int x, int bits) { int r = 0; for (int b = 0; b < bits; ++b) r |= ((x >> b) & 1) << (bits - 1 - b); return r; }
template <int R, int LOG, bool INV> __device__ __forceinline__ void reg_fft(float2 (&v)[R]) {
#pragma unroll
  for (int st = 0; st < LOG; ++st) {
    const int ln = R >> st, h = ln >> 1;
#pragma unroll
    for (int blk = 0; blk < R; blk += ln)
#pragma unroll
      for (int j = 0; j < h; ++j) {
        const float2 a = v[blk + j], b = v[blk + j + h];
        v[blk + j] = cadd(a, b);
        const float2 d = csub(a, b);
        const int tk = j * (32 / ln);
        if (tk == 0) v[blk + j + h] = d;
        else if (tk == 8) v[blk + j + h] = INV ? make_float2(-d.y, d.x) : make_float2(d.y, -d.x);
        else { const float c = tw32c(tk), s = tw32s(tk); v[blk + j + h] = cmul(d, make_float2(c, INV ? s : -s)); }
      }
    __builtin_amdgcn_sched_barrier(0);
  }
}
__device__ __forceinline__ void fft_fwd(float2* X, int tid) {
#pragma unroll 1
  for (int it = 0; it < 2; ++it) {
    const int i = tid + NTH * it;
    float2* xb = X + FP(i);
    float2 v[16];
#pragma unroll
    for (int m = 0; m < 16; ++m) v[m] = xb[1056 * m];
    __builtin_amdgcn_sched_barrier(0);
    reg_fft<16, 4, false>(v);
    float rv = (float)i * (1.0f / 16384.0f); asm volatile("" : "+v"(rv));
    const float2 w1 = make_float2(hw_cos_rev(rv), -hw_sin_rev(rv)); float2 w = w1;
    xb[0] = v[0];
#pragma unroll
    for (int r = 1; r < 16; ++r) { const int x = brev_n(r, 4); xb[1056 * r] = cmul(v[x], w); w = cmul(w, w1);  if ((r & 3) == 3) __builtin_amdgcn_sched_barrier(0); }
  }
  __syncthreads();
  {
    const int blk = tid >> 5, i = tid & 31;
    float2* xb = X + blk * 1056 + i;
    float2 v[32];
#pragma unroll
    for (int m = 0; m < 32; ++m) v[m] = xb[33 * m];
    __builtin_amdgcn_sched_barrier(0);
    reg_fft<32, 5, false>(v);
    float rv = (float)i * (1.0f / 1024.0f); asm volatile("" : "+v"(rv));
    const float2 w1 = make_float2(hw_cos_rev(rv), -hw_sin_rev(rv)); float2 w = w1;
    xb[0] = v[0];
#pragma unroll
    for (int r = 1; r < 32; ++r) { const int x = brev_n(r, 5); xb[33 * r] = cmul(v[x], w); w = cmul(w, w1);  if ((r & 3) == 3) __builtin_amdgcn_sched_barrier(0); }
  }
  __syncthreads();
  {
    float2* xb = X + 33 * tid;
    float2 v[32];
#pragma unroll
    for (int c = 0; c < 32; ++c) v[c] = xb[c];
    __builtin_amdgcn_sched_barrier(0);
    reg_fft<32, 5, false>(v);
#pragma unroll
    for (int x = 0; x < 32; ++x) xb[brev_n(x, 5)] = v[x];
  }
  __syncthreads();
}
__device__ __forceinline__ void fft_inv(float2* X, int tid) {
  {
    float2* xb = X + 33 * tid;
    float2 v[32];
#pragma unroll
    for (int c = 0; c < 32; ++c) v[c] = xb[c];
    __builtin_amdgcn_sched_barrier(0);
    reg_fft<32, 5, true>(v);
#pragma unroll
    for (int x = 0; x < 32; ++x) xb[brev_n(x, 5)] = v[x];
  }
  __syncthreads();
  {
    const int blk = tid >> 5, i = tid & 31;
    float2* xb = X + blk * 1056 + i;
    float2 v[32];
    float rv = (float)i * (1.0f / 1024.0f); asm volatile("" : "+v"(rv));
    const float2 w1 = make_float2(hw_cos_rev(rv), hw_sin_rev(rv)); float2 w = w1;
    v[0] = xb[0];
#pragma unroll
    for (int r = 1; r < 32; ++r) { v[r] = cmul(xb[33 * r], w); w = cmul(w, w1);  if ((r & 3) == 3) __builtin_amdgcn_sched_barrier(0); }
    __builtin_amdgcn_sched_barrier(0);
    reg_fft<32, 5, true>(v);
#pragma unroll
    for (int x = 0; x < 32; ++x) xb[33 * brev_n(x, 5)] = v[x];
  }
  __syncthreads();
#pragma unroll 1
  for (int it = 0; it < 2; ++it) {
    const int i = tid + NTH * it;
    float2* xb = X + FP(i);
    float2 v[16];
    float rv = (float)i * (1.0f / 16384.0f); asm volatile("" : "+v"(rv));
    const float2 w1 = make_float2(hw_cos_rev(rv), hw_sin_rev(rv)); float2 w = w1;
    v[0] = xb[0];
#pragma unroll
    for (int r = 1; r < 16; ++r) { v[r] = cmul(xb[1056 * r], w); w = cmul(w, w1);  if ((r & 3) == 3) __builtin_amdgcn_sched_barrier(0); }
    __builtin_amdgcn_sched_barrier(0);
    reg_fft<16, 4, true>(v);
#pragma unroll
    for (int x = 0; x < 16; ++x) xb[1056 * brev_n(x, 4)] = v[x];
  }
  __syncthreads();
}
__device__ __forceinline__ int fpos(int k) { return ((k & 15) << 10) | (((k >> 4) & 31) << 5) | (k >> 9); }

struct ConvC { float w0, w1, w2, cb, ib; };
__device__ __forceinline__ float uni(float v) { return __uint_as_float(__builtin_amdgcn_readfirstlane(__float_as_uint(v))); }
__device__ __forceinline__ ConvC conv_consts(KP p, int r) { ConvC c; c.w0 = uni(p->in[10][r]); c.w1 = uni(p->in[10][3072 + r]); c.w2 = uni(p->in[10][6144 + r]); c.cb = uni(p->in[11][r]); c.ib = uni(p->in[9][r]); return c; }
__device__ __forceinline__ float conv3(const bf16_t* row, int n, const ConvC& c) {
  const float ce = bf2f(row[n]) + c.ib; const float l0 = bf2f(row[n > 0 ? n - 1 : 0]) + c.ib; const float r0 = bf2f(row[n < SEQ - 1 ? n + 1 : SEQ - 1]) + c.ib;
  const float le = n > 0 ? l0 : 0.f; const float ri = n < SEQ - 1 ? r0 : 0.f;
  return c.w0 * le + c.w1 * ce + c.w2 * ri + c.cb;
}

typedef _Float16 h16x2 __attribute__((ext_vector_type(2)));
__device__ __forceinline__ unsigned pack_h2(float a, float b) { return cvt_pk_bf16(a, b); }
__device__ __forceinline__ float2 unpack_h2(unsigned w) { return make_float2(__uint_as_float(w << 16), __uint_as_float(w & 0xffff0000u)); }
__device__ __forceinline__ void ld32_sc0(const unsigned* p, u32x4 (&r)[8]) {
  asm volatile(
    "global_load_dwordx4 %0, %8, off sc0 sc1\n\t"
    "global_load_dwordx4 %1, %8, off offset:16 sc0 sc1\n\t"
    "global_load_dwordx4 %2, %8, off offset:32 sc0 sc1\n\t"
    "global_load_dwordx4 %3, %8, off offset:48 sc0 sc1\n\t"
    "global_load_dwordx4 %4, %8, off offset:64 sc0 sc1\n\t"
    "global_load_dwordx4 %5, %8, off offset:80 sc0 sc1\n\t"
    "global_load_dwordx4 %6, %8, off offset:96 sc0 sc1\n\t"
    "global_load_dwordx4 %7, %8, off offset:112 sc0 sc1\n\t"
    "s_waitcnt vmcnt(0)"
    : "=&v"(r[0]), "=&v"(r[1]), "=&v"(r[2]), "=&v"(r[3]), "=&v"(r[4]), "=&v"(r[5]), "=&v"(r[6]), "=&v"(r[7]) : "v"(p) : "memory");
}
struct Row32 { u32x4 q[4]; };
__device__ __forceinline__ Row32 ld_row32(const bf16_t* p) { Row32 r;
#pragma unroll
  for (int i = 0; i < 4; ++i) r.q[i] = *(const u32x4*)(p + 8 * i);
  return r; }
__device__ __forceinline__ float row_get(const Row32& r, int e) { const unsigned w = r.q[e >> 3][(e >> 1) & 3]; return (e & 1) ? __uint_as_float(w & 0xffff0000u) : __uint_as_float(w << 16); }
__device__ __forceinline__ void row_edges(const bf16_t* row, int tid, float ib, float& left, float& right) {
  const float l0 = bf2f(row[tid > 0 ? 32 * tid - 1 : 0]) + ib; left = tid > 0 ? l0 : 0.f;
  const float r0 = bf2f(row[tid < 511 ? 32 * tid + 32 : SEQ - 1]) + ib; right = tid < 511 ? r0 : 0.f;
}
__device__ __forceinline__ float conv_at(const Row32& r, int c, float left, float right, const ConvC& k) {
  const float ce = row_get(r, c) + k.ib;
  const float le = c > 0 ? row_get(r, c > 0 ? c - 1 : 0) + k.ib : left;
  const float ri = c < 31 ? row_get(r, c < 31 ? c + 1 : 31) + k.ib : right;
  return k.w0 * le + k.w1 * ce + k.w2 * ri + k.cb;
}

template <int MODE> __device__ __forceinline__ void hyena_unit(KP p, int pair, float2* X, int wave_id) {
  unsigned char* ws = p->ws;
  const int ca = 2 * pair, cb = ca + 1;
  const bf16_t* PT = (const bf16_t*)(ws + WS_PROJT);
  const bf16_t* FT = (const bf16_t*)(ws + WS_FILT);
  bf16_t* Z2 = (bf16_t*)(ws + WS_Z2);
  bf16_t* za = MODE ? (bf16_t*)(ws + WS_END) + (size_t)blockIdx.x * 2 * SEQ : Z2 + (size_t)ca * SEQ; bf16_t* zb = MODE ? za + SEQ : Z2 + (size_t)cb * SEQ;
  unsigned* KS = (unsigned*)(ws + WS_KS) + (size_t)blockIdx.x * SEQ;
  unsigned* YE = (unsigned*)(ws + WS_YE) + (size_t)blockIdx.x * SEQ;
  const ConvC cva = conv_consts(p, ca), cvb = conv_consts(p, cb);
  const bf16_t* va = PT + (size_t)ca * SEQ; const bf16_t* vb = PT + (size_t)cb * SEQ;
  const float invN = 1.0f / 32768.0f;
#pragma unroll 1
  for (int ord = 0; ord < 2; ++ord) {
    const ConvC cga = conv_consts(p, 1024 * (ord + 1) + ca), cgb = conv_consts(p, 1024 * (ord + 1) + cb);
    const bf16_t* ga = PT + (size_t)(1024 * (ord + 1) + ca) * SEQ; const bf16_t* gb = PT + (size_t)(1024 * (ord + 1) + cb) * SEQ;
    const float ska = uni(p->in[20][ord * 1024 + ca]), skb = uni(p->in[20][ord * 1024 + cb]);
    const bf16_t* faf = FT + (size_t)(ord * 2048 + ca) * SEQ; const bf16_t* fbf = FT + (size_t)(ord * 2048 + cb) * SEQ;
    const bf16_t* fab = FT + (size_t)(ord * 2048 + 1024 + ca) * SEQ; const bf16_t* fbb = FT + (size_t)(ord * 2048 + 1024 + cb) * SEQ;
    u32x4 yreg[7];
#pragma unroll
    for (int i = 0; i < 7; ++i) yreg[i] = (u32x4){0u, 0u, 0u, 0u};
#pragma unroll
    for (int half = 0; half < 2; ++half) {
      int tid = fresh_tid(wave_id);
      float2* xc; int n0;
#define HY_FRESH() do { tid = fresh_tid(wave_id); xc = X + 33 * tid; n0 = 32 * tid; } while (0)
      HY_FRESH();
      const float twr = half ? invN : 0.f;
      const float sgn = half ? -1.f : 1.f;
      {
        const Row32 rfa = ld_row32(faf + n0), rfb = ld_row32(fbf + n0);
        const Row32 rba = ld_row32(fab + (SEQ - 32 - n0)), rbb = ld_row32(fbb + (SEQ - 32 - n0));
        const int ex = tid ? SEQ - n0 : 0;
        float ea = bf2f(fab[ex]), eb = bf2f(fbb[ex]); ea = tid ? ea : 0.f; eb = tid ? eb : 0.f;
#pragma unroll
        for (int c = 0; c < 32; ++c) {
          const float kaf = row_get(rfa, c), kbf = row_get(rfb, c);
          const float kab = c ? row_get(rba, c ? 32 - c : 0) : ea, kbb = c ? row_get(rbb, c ? 32 - c : 0) : eb;
          const float r = (float)(n0 + c) * twr;
          xc[c] = cmul(make_float2(kaf + sgn * kab, kbf + sgn * kbb), make_float2(hw_cos_rev(r), -hw_sin_rev(r)));
        }
      }
      __syncthreads();
      if (MODE != 2) fft_fwd(X, tid);
      HY_FRESH();
      u32x4 kown[8];
#pragma unroll
      for (int i = 0; i < 8; ++i) { u32x4 o;
#pragma unroll
        for (int k = 0; k < 4; ++k) { const float2 a = xc[4 * i + k]; o[k] = pack_h2(a.x * 0.0625f, a.y * 0.0625f); }
        *(u32x4*)(KS + n0 + 4 * i) = o; kown[i] = o; }
      __syncthreads();
      HY_FRESH();
      if (ord == 0) {
        const Row32 ra = ld_row32(va + n0), rb = ld_row32(vb + n0);
        float la, ra_, lb, rb_; row_edges(va, tid, cva.ib, la, ra_); row_edges(vb, tid, cvb.ib, lb, rb_);
#pragma unroll
        for (int c = 0; c < 32; ++c) {
          const float r = (float)(n0 + c) * twr;
          xc[c] = cmul(make_float2(conv_at(ra, c, la, ra_, cva), conv_at(rb, c, lb, rb_, cvb)), make_float2(hw_cos_rev(r), -hw_sin_rev(r)));
        }
      } else {
#pragma unroll
        for (int g = 0; g < 8; ++g) {
          float a[4], b[4]; unpack4(*(const u32x2*)(za + n0 + 4 * g), a); unpack4(*(const u32x2*)(zb + n0 + 4 * g), b);
#pragma unroll
          for (int k = 0; k < 4; ++k) { const float r = (float)(n0 + 4 * g + k) * twr; xc[4 * g + k] = cmul(make_float2(a[k], b[k]), make_float2(hw_cos_rev(r), -hw_sin_rev(r))); }
        }
      }
      __syncthreads();
      if (MODE != 2) fft_fwd(X, tid);
      {
        HY_FRESH();
        const int jb = ((tid >> 5) & 15) | ((tid & 31) << 4);
        const int jp0 = half ? (SEQ - 1 - jb) : ((SEQ - jb) & (SEQ - 1));
        const bool special = (half == 0) && (tid == 0);
        const int chq = special ? 0 : (fpos(jp0) >> 5);
        const float2* xq = X + 33 * chq;
        u32x4 kq[8], kpv[8];
        ld32_sc0(KS + 32 * chq, kq);
        if (half) ld32_sc0(KS + n0, kpv);
        else {
#pragma unroll
          for (int i = 0; i < 8; ++i) kpv[i] = kown[i]; }
        float2 wr[32];
#pragma unroll
        for (int i = 0; i < 8; ++i) {
          const u32x4 kp = kpv[i];
#pragma unroll
          for (int k = 0; k < 4; ++k) {
            const int c = 4 * i + k;
            const int e1 = 31 - c, e2 = (32 - c) & 31;
            const float2 Zp = xc[c]; float2 Zq = xq[special ? e2 : e1]; Zq.y = -Zq.y;
            const float2 Kp = unpack_h2(kp[k]);
            float2 Kq = unpack_h2(special ? kq[e2 >> 2][e2 & 3] : kq[e1 >> 2][e1 & 3]); Kq.y = -Kq.y;
            const float2 Ua = make_float2(0.5f * (Zp.x + Zq.x), 0.5f * (Zp.y + Zq.y));
            const float2 dz = csub(Zp, Zq); const float2 Ub = make_float2(0.5f * dz.y, -0.5f * dz.x);
            const float2 Ka = make_float2(0.5f * (Kp.x + Kq.x), 0.5f * (Kp.y + Kq.y));
            const float2 dk = csub(Kp, Kq); const float2 Kb = make_float2(0.5f * dk.y, -0.5f * dk.x);
            const float2 P = cmul(Ua, Ka), Q = cmul(Ub, Kb);
            wr[c] = make_float2(P.x - Q.y, P.y + Q.x);
          }
        }
        __syncthreads();
#pragma unroll
        for (int c = 0; c < 32; ++c) xc[c] = wr[c];
      }
      __syncthreads();
      if (MODE != 2) fft_inv(X, tid);
      if (half == 0) {
#pragma unroll
        for (int i = 0; i < 8; ++i) { u32x4 o;
#pragma unroll
        for (int k = 0; k < 4; ++k) { const float2 a = xc[4 * i + k]; o[k] = pack_h2(a.x * (16.0f * invN), a.y * (16.0f * invN)); }
        if (i < 7) yreg[i] = o; else *(u32x4*)(YE + n0 + 28) = o; }
      } else {
        HY_FRESH();
        const Row32 rga = ld_row32(ga + n0), rgb = ld_row32(gb + n0);
        float lga, rga_, lgb, rgb_; row_edges(ga, tid, cga.ib, lga, rga_); row_edges(gb, tid, cgb.ib, lgb, rgb_);
        Row32 ra, rb; float la = 0.f, ra_ = 0.f, lb = 0.f, rb_ = 0.f;
        if (ord == 0) { ra = ld_row32(va + n0); rb = ld_row32(vb + n0); row_edges(va, tid, cva.ib, la, ra_); row_edges(vb, tid, cvb.ib, lb, rb_); }
        u32x4 ylast;
        asm volatile("global_load_dwordx4 %0, %1, off sc0 sc1\n\ts_waitcnt vmcnt(0)" : "=&v"(ylast) : "v"(YE + n0 + 28) : "memory");
#pragma unroll
        for (int g = 0; g < 8; ++g) {
          f32x4 ua4, ub4;
          if (ord == 0) {
#pragma unroll
            for (int k = 0; k < 4; ++k) { ua4[k] = conv_at(ra, 4 * g + k, la, ra_, cva); ub4[k] = conv_at(rb, 4 * g + k, lb, rb_, cvb); }
          } else { float a[4], b[4]; unpack4(*(const u32x2*)(za + n0 + 4 * g), a); unpack4(*(const u32x2*)(zb + n0 + 4 * g), b);
#pragma unroll
            for (int k = 0; k < 4; ++k) { ua4[k] = a[k]; ub4[k] = b[k]; } }
          const u32x4 yew = (g < 7) ? yreg[g < 7 ? g : 0] : ylast;
          f32x4 oa, ob;
#pragma unroll
          for (int k = 0; k < 4; ++k) {
            const int c = 4 * g + k;
            const float r = (float)(n0 + c) * invN;
            const float2 yo = cmul(make_float2(hw_cos_rev(r), hw_sin_rev(r)), xc[c]);
            const float2 ye = unpack_h2(yew[k]);
            const float ya = ye.x + yo.x * (16.0f * invN), yb = ye.y + yo.y * (16.0f * invN);
            oa[k] = conv_at(rga, c, lga, rga_, cga) * (ya + ska * ua4[k]);
            ob[k] = conv_at(rgb, c, lgb, rgb_, cgb) * (yb + skb * ub4[k]);
          }
          { u32x2 wa, wb; wa.x = cvt_pk_bf16(oa[0], oa[1]); wa.y = cvt_pk_bf16(oa[2], oa[3]); wb.x = cvt_pk_bf16(ob[0], ob[1]); wb.y = cvt_pk_bf16(ob[2], ob[3]);
            *(u32x2*)(za + n0 + 4 * g) = wa; *(u32x2*)(zb + n0 + 4 * g) = wb; }
        }
      }
      __syncthreads();
    }
  }
#undef HY_FRESH
}

__device__ __forceinline__ void hy_headnorm_unit(KP p, int u, float* sm, int tid) {
  const int hh = u >> 8, t0 = (u & 255) << 6;
  const bf16_t* Z2 = (const bf16_t*)(p->ws + WS_Z2) + (size_t)(hh * 128) * SEQ + t0;
  for (int i = tid; i < 128 * 16; i += NTH) { const int c = i >> 4, t4 = (i & 15) << 2; float v[4]; unpack4(*(const u32x2*)(Z2 + (size_t)c * SEQ + t4), v); float* d = sm + c * 65 + t4; d[0] = v[0]; d[1] = v[1]; d[2] = v[2]; d[3] = v[3]; }
  __syncthreads();
  float* part = sm + 128 * 65;
  { const int t = tid & 63, pt = tid >> 6; float s = 0.f;
#pragma unroll
    for (int c = 0; c < 16; ++c) { const float v = sm[(pt * 16 + c) * 65 + t]; s += v * v; }
    part[pt * 64 + t] = s; }
  __syncthreads();
  const float* gn = p->in[21] + hh * 128;
  bf16_t* Y = (bf16_t*)(p->ws + WS_YMIX);
  for (int i = tid; i < 64 * 16; i += NTH) {
    const int t = i >> 4, c0 = (i & 15) << 3;
    float s = 0.f;
#pragma unroll
    for (int k = 0; k < 8; ++k) s += part[k * 64 + t];
    const float rstd = rsqrtf(s * (1.0f / 128.0f) + 1e-6f);
    float v[8];
#pragma unroll
    for (int k = 0; k < 8; ++k) v[k] = sm[(c0 + k) * 65 + t] * rstd * gn[c0 + k];
    u32x4 o; o.x = cvt_pk_bf16(v[0], v[1]); o.y = cvt_pk_bf16(v[2], v[3]); o.z = cvt_pk_bf16(v[4], v[5]); o.w = cvt_pk_bf16(v[6], v[7]);
    *(u32x4*)(Y + (size_t)(t0 + t) * DM + hh * 128 + c0) = o;
  }
  __syncthreads();
}

constexpr int HG_QIN = 0, HG_KIN = 17408, HG_KST = 34816, HG_VT = 53248, HG_AM = 71680, HG_ST = 80896, HG_PART = 115712, HG_DEC = 117760;
struct HgSrc { const bf16_t* q; const bf16_t* v; const bf16_t* f; int ld; int len; };

__device__ __forceinline__ void lds_barrier() { asm volatile("s_waitcnt lgkmcnt(0)\n\ts_barrier" ::: "memory"); }
struct HgRaw { unsigned fv[16]; unsigned q2[8]; };
template <bool WITHQ>
__device__ __forceinline__ void hg_load(const HgSrc& s, int dir, int n, int tid, HgRaw& r) {
  const int k = tid & 127, sg = tid >> 7;
  const int sp0 = n * 64 + sg * 16; const int tb = dir ? (s.len - 1 - sp0) : sp0; const int step = dir ? -s.ld : s.ld;
  const size_t ob = (size_t)tb * s.ld + k;
  const bf16_t* pf = s.f + ob; const bf16_t* pv = s.v + ob; const bf16_t* pq = s.q + ob;
#pragma unroll
  for (int j = 0; j < 16; j += 2) {
    const int r0 = j * step, r1 = (j + 1) * step;
    r.fv[j] = (unsigned)pf[r0] | ((unsigned)pv[r0] << 16); r.fv[j + 1] = (unsigned)pf[r1] | ((unsigned)pv[r1] << 16);
    if (WITHQ) r.q2[j >> 1] = (unsigned)pq[r0] | ((unsigned)pq[r1] << 16);
  }
}
template <bool WITHQ>
__device__ __forceinline__ float hg_prep(const HgRaw& r, float lbk, unsigned char* shm, int tid) {
  const int k = tid & 127, sg = tid >> 7;
  bf16_t* QIN = (bf16_t*)(shm + HG_QIN); bf16_t* KIN = (bf16_t*)(shm + HG_KIN); bf16_t* KST = (bf16_t*)(shm + HG_KST); bf16_t* VT = (bf16_t*)(shm + HG_VT);
  float* PART = (float*)(shm + HG_PART); float* DEC = (float*)(shm + HG_DEC);
  float bl[16], kk[16]; float run = 0.f;
#pragma unroll
  for (int j = 0; j < 16; ++j) {
    const float f = lbk + (1.0f - lbk) * sigmoidf_(__uint_as_float(r.fv[j] << 16));
    run += __logf(f); bl[j] = run; kk[j] = 1.0f - f;
  }
  PART[sg * 128 + k] = run;
  lds_barrier();
  float off = 0.f;
#pragma unroll
  for (int g = 0; g < 4; ++g) off += (g < sg) ? PART[g * 128 + k] : 0.f;
  const float tot = PART[k] + PART[128 + k] + PART[256 + k] + PART[384 + k];
  float kst[16];
  const float etot = __expf(tot);
#pragma unroll
  for (int j = 0; j < 16; ++j) {
    const int sl = sg * 16 + j;
    const float b = off + bl[j];
    if (WITHQ) {
      const float qr = (j & 1) ? __uint_as_float(r.q2[j >> 1] & 0xffff0000u) : __uint_as_float(r.q2[j >> 1] << 16);
      const float kin = kk[j] * __expf(-b);
      QIN[sl * 136 + k] = f2bf(qr * sigmoidf_(qr) * __expf(b));
      KIN[sl * 136 + k] = f2bf(kin);
      kst[j] = kin * etot;
    } else kst[j] = kk[j] * __expf(tot - b);
  }
  {
    u32x4 a0, a1, v0, v1;
#pragma unroll
    for (int i = 0; i < 4; ++i) { a0[i] = cvt_pk_bf16(kst[2 * i], kst[2 * i + 1]); a1[i] = cvt_pk_bf16(kst[8 + 2 * i], kst[8 + 2 * i + 1]);
      v0[i] = (r.fv[2 * i] >> 16) | (r.fv[2 * i + 1] & 0xffff0000u); v1[i] = (r.fv[8 + 2 * i] >> 16) | (r.fv[8 + 2 * i + 1] & 0xffff0000u); }
    *(u32x4*)(KST + k * 72 + sg * 16) = a0; *(u32x4*)(KST + k * 72 + sg * 16 + 8) = a1;
    *(u32x4*)(VT + k * 72 + sg * 16) = v0; *(u32x4*)(VT + k * 72 + sg * 16 + 8) = v1;
  }
  if (sg == 0) DEC[k] = etot;
  lds_barrier();
  return tot;
}

__device__ __forceinline__ void hg_state_update(f32x4 (&Sacc)[8], unsigned char* shm, int wv, int fr, int fq) {
  const bf16_t* KST = (const bf16_t*)(shm + HG_KST); const bf16_t* VT = (const bf16_t*)(shm + HG_VT); const float* DEC = (const float*)(shm + HG_DEC);
  float dc[4];
#pragma unroll
  for (int j = 0; j < 4; ++j) dc[j] = DEC[16 * wv + fq * 4 + j];
#pragma unroll
  for (int nt = 0; nt < 8; ++nt)
#pragma unroll
    for (int j = 0; j < 4; ++j) Sacc[nt][j] *= dc[j];
#pragma unroll
  for (int ks = 0; ks < 2; ++ks) {
    const bf16x8 a = *(const bf16x8*)(KST + (16 * wv + fr) * 72 + ks * 32 + fq * 8);
#pragma unroll
    for (int nt = 0; nt < 8; ++nt) {
      const bf16x8 b = *(const bf16x8*)(VT + (nt * 16 + fr) * 72 + ks * 32 + fq * 8);
      Sacc[nt] = __builtin_amdgcn_mfma_f32_16x16x32_bf16(a, b, Sacc[nt], 0, 0, 0);
    }
  }
}
__device__ __forceinline__ void hg_write_st(const f32x4 (&Sacc)[8], unsigned char* shm, int wv, int fr, int fq) {
  bf16_t* ST = (bf16_t*)(shm + HG_ST);
#pragma unroll
  for (int nt = 0; nt < 8; ++nt) {
    u32x2 w; w.x = cvt_pk_bf16(Sacc[nt][0], Sacc[nt][1]); w.y = cvt_pk_bf16(Sacc[nt][2], Sacc[nt][3]);
    *(u32x2*)(ST + (nt * 16 + fr) * 136 + 16 * wv + fq * 4) = w;
  }
}
__device__ __forceinline__ HgSrc hg_src(KP p, int h, int d, bool ctx) {
  HgSrc s;
  if (ctx) { const bf16_t* P = (const bf16_t*)(p->ws + WS_PCB) + h * 128; s.q = P; s.v = P; s.f = P + (1 + d) * 1024; s.ld = 3072; s.len = CTXL; }
  else { const bf16_t* P = (const bf16_t*)(p->ws + WS_PROJG) + h * 128; s.q = P; s.v = P + 1024; s.f = P + (2 + d) * 1024; s.ld = 5120; s.len = SEQ; }
  return s;
}
constexpr int HG_KST2 = HG_QIN, HG_VT2 = HG_ST, HG_PART2 = HG_DEC + 512, HG_DEC2 = HG_DEC + 512 + 2048;
struct HgA { float bl[16]; unsigned kk2[8]; };
__device__ __forceinline__ void hg1_stage_a(const HgRaw& r, float lbk, float* PART, int tid, HgA& a) {
  const int k = tid & 127, sg = tid >> 7; float run = 0.f; float kkf[16];
#pragma unroll
  for (int j = 0; j < 16; ++j) {
    const float f = lbk + (1.0f - lbk) * sigmoidf_(__uint_as_float(r.fv[j] << 16));
    run += __logf(f); a.bl[j] = run; kkf[j] = 1.0f - f;
  }
#pragma unroll
  for (int i = 0; i < 8; ++i) a.kk2[i] = cvt_pk_bf16(kkf[2 * i], kkf[2 * i + 1]);
  PART[sg * 128 + k] = run;
}
__device__ __forceinline__ float hg1_stage_b(const HgRaw& r, const HgA& a, unsigned char* shm, int kst_off, int vt_off, int part_off, int dec_off, int tid) {
  const int k = tid & 127, sg = tid >> 7;
  bf16_t* KST = (bf16_t*)(shm + kst_off); bf16_t* VT = (bf16_t*)(shm + vt_off); const float* PART = (const float*)(shm + part_off); float* DEC = (float*)(shm + dec_off);
  float off = 0.f;
#pragma unroll
  for (int g = 0; g < 4; ++g) off += (g < sg) ? PART[g * 128 + k] : 0.f;
  const float tot = PART[k] + PART[128 + k] + PART[256 + k] + PART[384 + k];
  float kst[16];
#pragma unroll
  for (int j = 0; j < 16; ++j) { const float kkj = (j & 1) ? __uint_as_float(a.kk2[j >> 1] & 0xffff0000u) : __uint_as_float(a.kk2[j >> 1] << 16); kst[j] = kkj * __expf(tot - (off + a.bl[j])); }
  u32x4 a0, a1, v0, v1;
#pragma unroll
  for (int i = 0; i < 4; ++i) { a0[i] = cvt_pk_bf16(kst[2 * i], kst[2 * i + 1]); a1[i] = cvt_pk_bf16(kst[8 + 2 * i], kst[8 + 2 * i + 1]);
    v0[i] = (r.fv[2 * i] >> 16) | (r.fv[2 * i + 1] & 0xffff0000u); v1[i] = (r.fv[8 + 2 * i] >> 16) | (r.fv[8 + 2 * i + 1] & 0xffff0000u); }
  *(u32x4*)(KST + k * 72 + sg * 16) = a0; *(u32x4*)(KST + k * 72 + sg * 16 + 8) = a1;
  *(u32x4*)(VT + k * 72 + sg * 16) = v0; *(u32x4*)(VT + k * 72 + sg * 16 + 8) = v1;
  if (sg == 0) DEC[k] = __expf(tot);
  return tot;
}
__device__ __forceinline__ void hg_state_update_at(f32x4 (&Sacc)[8], unsigned char* shm, int kst_off, int vt_off, int dec_off, int wv, int fr, int fq) {
  const bf16_t* KST = (const bf16_t*)(shm + kst_off); const bf16_t* VT = (const bf16_t*)(shm + vt_off); const float* DEC = (const float*)(shm + dec_off);
  float dc[4];
#pragma unroll
  for (int j = 0; j < 4; ++j) dc[j] = DEC[16 * wv + fq * 4 + j];
#pragma unroll
  for (int nt = 0; nt < 8; ++nt)
#pragma unroll
    for (int j = 0; j < 4; ++j) Sacc[nt][j] *= dc[j];
#pragma unroll
  for (int ks = 0; ks < 2; ++ks) {
    const bf16x8 a = *(const bf16x8*)(KST + (16 * wv + fr) * 72 + ks * 32 + fq * 8);
#pragma unroll
    for (int nt = 0; nt < 8; ++nt) {
      const bf16x8 b = *(const bf16x8*)(VT + (nt * 16 + fr) * 72 + ks * 32 + fq * 8);
      Sacc[nt] = __builtin_amdgcn_mfma_f32_16x16x32_bf16(a, b, Sacc[nt], 0, 0, 0);
    }
  }
}
__device__ __forceinline__ void hg1_unit(KP p, int u, unsigned char* shm, int tid) {
  const bool ctx = u >= 256; const int hd = ctx ? (u - 256) : (u >> 4); const int sc = ctx ? 0 : (u & 15); const int h = hd >> 1, d = hd & 1;
  const HgSrc s = hg_src(p, h, d, ctx);
  const int lane = tid & 63, wv = tid >> 6, fr = lane & 15, fq = lane >> 4;
  const float lbk = ((const float*)(p->ws + WS_LBS))[h * 128 + (tid & 127)];
  f32x4 Sacc[8];
#pragma unroll
  for (int nt = 0; nt < 8; ++nt) Sacc[nt] = (f32x4){0.f, 0.f, 0.f, 0.f};
  float dsum = 0.f;
  const int nch = ctx ? 4 : 16;
  HgRaw c0, c1; hg_load<false>(s, d, sc * 16, tid, c0); hg_load<false>(s, d, sc * 16 + 1, tid, c1);
#pragma unroll 1
  for (int c = 0; c < nch; c += 2) {
    HgRaw n0, n1;
    hg_load<false>(s, d, sc * 16 + (c + 2 < nch ? c + 2 : c), tid, n0); hg_load<false>(s, d, sc * 16 + (c + 2 < nch ? c + 3 : c + 1), tid, n1);
    HgA a0, a1;
    hg1_stage_a(c0, lbk, (float*)(shm + HG_PART), tid, a0); hg1_stage_a(c1, lbk, (float*)(shm + HG_PART2), tid, a1);
    lds_barrier();
    dsum += hg1_stage_b(c0, a0, shm, HG_KST, HG_VT, HG_PART, HG_DEC, tid);
    dsum += hg1_stage_b(c1, a1, shm, HG_KST2, HG_VT2, HG_PART2, HG_DEC2, tid);
    lds_barrier();
    hg_state_update_at(Sacc, shm, HG_KST, HG_VT, HG_DEC, wv, fr, fq);
    hg_state_update_at(Sacc, shm, HG_KST2, HG_VT2, HG_DEC2, wv, fr, fq);
    lds_barrier();
    c0 = n0; c1 = n1;
  }
  float* dst = ctx ? ((float*)(p->ws + WS_S0) + (size_t)hd * 16384) : ((float*)(p->ws + WS_SLOC) + (size_t)(hd * 16 + sc) * 16384);
#pragma unroll
  for (int nt = 0; nt < 8; ++nt)
#pragma unroll
    for (int j = 0; j < 4; ++j) dst[(16 * wv + fq * 4 + j) * 128 + nt * 16 + fr] = Sacc[nt][j];
  if (!ctx && tid < 128) ((float*)(p->ws + WS_DLOC))[(hd * 16 + sc) * 128 + tid] = __expf(dsum);
}
__device__ __forceinline__ void hg2_unit(KP p, int u, unsigned char* shm, int tid) {
  const int hd = u >> 4, sc = u & 15, h = hd >> 1, d = hd & 1;
  const HgSrc s = hg_src(p, h, d, false);
  const int lane = tid & 63, wv = tid >> 6, fr = lane & 15, fq = lane >> 4;
  const float lbk = ((const float*)(p->ws + WS_LBS))[h * 128 + (tid & 127)];
  f32x4 Sacc[8];
  {
    const float* S0 = (const float*)(p->ws + WS_S0) + (size_t)hd * 16384;
#pragma unroll
    for (int nt = 0; nt < 8; ++nt)
#pragma unroll
      for (int j = 0; j < 4; ++j) Sacc[nt][j] = S0[(16 * wv + fq * 4 + j) * 128 + nt * 16 + fr];
#pragma unroll 4
    for (int q = 0; q < sc; ++q) {
      const float* SL = (const float*)(p->ws + WS_SLOC) + (size_t)(hd * 16 + q) * 16384; const float* DL = (const float*)(p->ws + WS_DLOC) + (hd * 16 + q) * 128;
#pragma unroll
      for (int j = 0; j < 4; ++j) { const float dc = DL[16 * wv + fq * 4 + j];
#pragma unroll
        for (int nt = 0; nt < 8; ++nt) Sacc[nt][j] = dc * Sacc[nt][j] + SL[(16 * wv + fq * 4 + j) * 128 + nt * 16 + fr]; }
    }
  }
  hg_write_st(Sacc, shm, wv, fr, fq);
  __syncthreads();
  const bf16_t* QIN = (const bf16_t*)(shm + HG_QIN); const bf16_t* KIN = (const bf16_t*)(shm + HG_KIN); const bf16_t* VT = (const bf16_t*)(shm + HG_VT);
  bf16_t* AM = (bf16_t*)(shm + HG_AM); const bf16_t* ST = (const bf16_t*)(shm + HG_ST);
  bf16_t* OF = (bf16_t*)(p->ws + WS_OFB) + (size_t)d * SEQ * 1024 + h * 128;
  HgRaw cur; hg_load<true>(s, d, sc * 16, tid, cur);
#pragma unroll 1
  for (int c = 0; c < 16; ++c) {
    const int n = sc * 16 + c;
    HgRaw nxt; hg_load<true>(s, d, sc * 16 + (c + 1 < 16 ? c + 1 : c), tid, nxt);
    hg_prep<true>(cur, lbk, shm, tid);
#pragma unroll
    for (int i = 0; i < 2; ++i) {
      const int tt = wv + 8 * i; const int mt = tt >> 2, nt = tt & 3;
      f32x4 acc = (f32x4){0.f, 0.f, 0.f, 0.f};
      if (nt <= mt) {
#pragma unroll
        for (int ks = 0; ks < 4; ++ks) {
          const bf16x8 a = *(const bf16x8*)(QIN + (mt * 16 + fr) * 136 + ks * 32 + fq * 8);
          const bf16x8 b = *(const bf16x8*)(KIN + (nt * 16 + fr) * 136 + ks * 32 + fq * 8);
          acc = __builtin_amdgcn_mfma_f32_16x16x32_bf16(a, b, acc, 0, 0, 0);
        }
      }
#pragma unroll
      for (int j = 0; j < 4; ++j) { const int t = mt * 16 + fq * 4 + j, sl = nt * 16 + fr; AM[t * 72 + sl] = f2bf(sl <= t ? acc[j] : 0.f); }
    }
    lds_barrier();
    {
      const int mt = wv & 3, nb = (wv >> 2) * 4;
      f32x4 oacc[4];
#pragma unroll
      for (int x = 0; x < 4; ++x) oacc[x] = (f32x4){0.f, 0.f, 0.f, 0.f};
#pragma unroll
      for (int ks = 0; ks < 2; ++ks) {
        const bf16x8 a = *(const bf16x8*)(AM + (mt * 16 + fr) * 72 + ks * 32 + fq * 8);
#pragma unroll
        for (int x = 0; x < 4; ++x) { const bf16x8 b = *(const bf16x8*)(VT + ((nb + x) * 16 + fr) * 72 + ks * 32 + fq * 8); oacc[x] = __builtin_amdgcn_mfma_f32_16x16x32_bf16(a, b, oacc[x], 0, 0, 0); }
      }
#pragma unroll
      for (int ks = 0; ks < 4; ++ks) {
        const bf16x8 a = *(const bf16x8*)(QIN + (mt * 16 + fr) * 136 + ks * 32 + fq * 8);
#pragma unroll
        for (int x = 0; x < 4; ++x) { const bf16x8 b = *(const bf16x8*)(ST + ((nb + x) * 16 + fr) * 136 + ks * 32 + fq * 8); oacc[x] = __builtin_amdgcn_mfma_f32_16x16x32_bf16(a, b, oacc[x], 0, 0, 0); }
      }
#pragma unroll
      for (int j = 0; j < 4; ++j) {
        const int sp = n * 64 + mt * 16 + fq * 4 + j; const int t = d ? (SEQ - 1 - sp) : sp;
#pragma unroll
        for (int x = 0; x < 4; ++x) OF[(size_t)t * 1024 + (nb + x) * 16 + fr] = f2bf(oacc[x][j]);
      }
    }
    hg_state_update(Sacc, shm, wv, fr, fq);
    lds_barrier();
    hg_write_st(Sacc, shm, wv, fr, fq);
    cur = nxt;
  }
  __syncthreads();
}
__device__ __forceinline__ void phase_hgcomb(KP p, int tid) {
  const bf16_t* OF = (const bf16_t*)(p->ws + WS_OFB); const bf16_t* PG = (const bf16_t*)(p->ws + WS_PROJG); bf16_t* Y = (bf16_t*)(p->ws + WS_YMIX);
  const int lane = tid & 63, sub = lane >> 5, l32 = lane & 31; const int gw = blockIdx.x * 8 + (tid >> 6), nw = gridDim.x * 8;
#pragma unroll 4
  for (int it = gw; it < SEQ * 4; it += nw) {
    const int grp = it * 2 + sub; const int t = grp >> 3, h = grp & 7; const int c = h * 128 + l32 * 4;
    const u32x2 ar = *(const u32x2*)(OF + (size_t)t * 1024 + c), br = *(const u32x2*)(OF + (size_t)(SEQ + t) * 1024 + c);
    f32x4 o; o[0] = __uint_as_float(ar.x << 16) + __uint_as_float(br.x << 16); o[1] = __uint_as_float(ar.x & 0xffff0000u) + __uint_as_float(br.x & 0xffff0000u);
    o[2] = __uint_as_float(ar.y << 16) + __uint_as_float(br.y << 16); o[3] = __uint_as_float(ar.y & 0xffff0000u) + __uint_as_float(br.y & 0xffff0000u);
    float ss = o[0] * o[0] + o[1] * o[1] + o[2] * o[2] + o[3] * o[3];
#pragma unroll
    for (int m = 1; m < 32; m <<= 1) ss += shfl_xor_l(ss, m, lane);
    const float rstd = rsqrtf(ss * (1.0f / 128.0f) + 1e-6f);
    const f32x4 gn = *(const f32x4*)(p->in[23] + c);
    const u32x2 gr = *(const u32x2*)(PG + (size_t)t * 5120 + 4096 + c);
    float g[4] = {__uint_as_float(gr.x << 16), __uint_as_float(gr.x & 0xffff0000u), __uint_as_float(gr.y << 16), __uint_as_float(gr.y & 0xffff0000u)};
    float r[4];
#pragma unroll
    for (int k = 0; k < 4; ++k) r[k] = o[k] * rstd * gn[k] * g[k] * sigmoidf_(g[k]);
    u32x2 w; w.x = cvt_pk_bf16(r[0], r[1]); w.y = cvt_pk_bf16(r[2], r[3]);
    *(u32x2*)(Y + (size_t)t * DM + 1024 + c) = w;
  }
}

__device__ __forceinline__ void unpack8(const u32x4 r, float (&v)[8]) {
  v[0] = __uint_as_float(r.x << 16); v[1] = __uint_as_float(r.x & 0xffff0000u); v[2] = __uint_as_float(r.y << 16); v[3] = __uint_as_float(r.y & 0xffff0000u);
  v[4] = __uint_as_float(r.z << 16); v[5] = __uint_as_float(r.z & 0xffff0000u); v[6] = __uint_as_float(r.w << 16); v[7] = __uint_as_float(r.w & 0xffff0000u);
}
__device__ __forceinline__ float gelu_as(float v) {
  const float av = fabsf(v); const float t = __builtin_amdgcn_rcpf(av * 0.2316418882f + 1.0f);
  float q = t * 0.5307027145f + (-0.7265760135f); q = q * t + 0.7107068705f; q = q * t + (-0.142248368f); q = q * t + 0.127414796f; q = q * t;
  const float e = __builtin_amdgcn_exp2f((v * v) * (-0.72134752044f));
  const float m = v * (q * e);
  return v < 0.f ? m : v - m;
}
__device__ __forceinline__ void phase_conv(KP p, int l, int tid) {
  const bf16_t* A = (const bf16_t*)(p->ws + WS_ABUF); const bf16_t* U = (const bf16_t*)(p->ws + WS_UBUF); bf16_t* G = (bf16_t*)(p->ws + WS_GBUF);
  const float* cw = p->in[29] + (size_t)l * 9 * DFF; const float* cbias = p->in[30] + (size_t)l * DFF;
  constexpr int RB = 2, CB = 2;
  const int total = (256 / RB) * 4 * 1408;
#pragma unroll 1
  for (int it = blockIdx.x * NTH + tid; it < total; it += gridDim.x * NTH) {
    const int cc = it % 1408; const int rs = it / 1408; const int sgm = rs & 3, r0 = (rs >> 2) * RB; const int c0 = cc * 4;
    f32x4 w[9];
#pragma unroll
    for (int k = 0; k < 9; ++k) w[k] = *(const f32x4*)(cw + k * DFF + c0);
    const f32x4 bsv = *(const f32x4*)(cbias + c0);
    const bf16_t* rowp[RB + 2]; bool rv[RB + 2];
#pragma unroll
    for (int di = 0; di < RB + 2; ++di) { const int rr = r0 + di - 1; rv[di] = (rr >= 0) && (rr < 256); const int rc = rr < 0 ? 0 : (rr > 255 ? 255 : rr); rowp[di] = A + (size_t)(rc * 64) * DFF + c0; }
    float win[3][RB + 2][4];
    const int j0 = sgm * 16;
    {
      u32x2 ra[2][RB + 2];
#pragma unroll
      for (int s = 0; s < 2; ++s) { const int col = j0 - 1 + s; const int cl = col < 0 ? 0 : col;
#pragma unroll
        for (int di = 0; di < RB + 2; ++di) ra[s][di] = *(const u32x2*)(rowp[di] + (size_t)cl * DFF); }
#pragma unroll
      for (int s = 0; s < 2; ++s) { const int col = j0 - 1 + s;
#pragma unroll
        for (int di = 0; di < RB + 2; ++di) { const bool ok = rv[di] && (col >= 0); unpack4(ra[s][di], win[s][di]);
#pragma unroll
          for (int k = 0; k < 4; ++k) win[s][di][k] = ok ? win[s][di][k] : 0.f; } }
    }
#pragma unroll 1
    for (int jb = j0; jb < j0 + 16; jb += CB) {
      u32x2 an[CB][RB + 2], ur[CB][RB];
#pragma unroll
      for (int q = 0; q < CB; ++q) { const int col = jb + q + 1; const int cl = col > 63 ? 63 : col;
#pragma unroll
        for (int di = 0; di < RB + 2; ++di) an[q][di] = *(const u32x2*)(rowp[di] + (size_t)cl * DFF);
#pragma unroll
        for (int rr = 0; rr < RB; ++rr) ur[q][rr] = *(const u32x2*)(U + (size_t)((r0 + rr) * 64 + jb + q) * DFF + c0); }
      __builtin_amdgcn_sched_barrier(0);
#pragma unroll
      for (int q = 0; q < CB; ++q) {
        const int col = jb + q + 1;
#pragma unroll
        for (int di = 0; di < RB + 2; ++di) { const bool ok = rv[di] && (col < 64); unpack4(an[q][di], win[2][di]);
#pragma unroll
          for (int k = 0; k < 4; ++k) win[2][di][k] = ok ? win[2][di][k] : 0.f; }
#pragma unroll
        for (int rr = 0; rr < RB; ++rr) {
          float uv[4]; unpack4(ur[q][rr], uv);
          float o[4];
#pragma unroll
          for (int k = 0; k < 4; ++k) {
            float a = bsv[k];
#pragma unroll
            for (int di = 0; di < 3; ++di)
#pragma unroll
              for (int dj = 0; dj < 3; ++dj) a += win[dj][rr + di][k] * w[di * 3 + dj][k];
            o[k] = gelu_as(a) * uv[k];
          }
          u32x2 ow; ow.x = cvt_pk_bf16(o[0], o[1]); ow.y = cvt_pk_bf16(o[2], o[3]);
          *(u32x2*)(G + (size_t)((r0 + rr) * 64 + jb + q) * DFF + c0) = ow;
        }
#pragma unroll
        for (int di = 0; di < RB + 2; ++di)
#pragma unroll
          for (int k = 0; k < 4; ++k) { win[0][di][k] = win[1][di][k]; win[1][di][k] = win[2][di][k]; }
      }
    }
  }
}
template <int HW> __device__ __forceinline__ void pma_run(const bf16_t* HA, bf16_t* PM, int gi, int t0, int c0) {
  constexpr int R = 8 + 2 * HW - 1;
  u32x4 raw[R];
#pragma unroll
  for (int i = 0; i < R; ++i) { int q = t0 - HW + i; q = q < 0 ? 0 : (q > SEQ - 1 ? SEQ - 1 : q); raw[i] = *(const u32x4*)(HA + (size_t)q * DM + c0); }
  float s[8];
#pragma unroll
  for (int k = 0; k < 8; ++k) s[k] = 0.f;
#pragma unroll
  for (int i = 0; i < 2 * HW; ++i) { const int q = t0 - HW + i; const bool ok = (q >= 0) && (q < SEQ); float v[8]; unpack8(raw[i], v);
#pragma unroll
    for (int k = 0; k < 8; ++k) s[k] += ok ? v[k] : 0.f; }
#pragma unroll
  for (int o = 0; o < 8; ++o) {
    const int t = t0 + o;
    if (o > 0) {
      const int qa = t + HW - 1, qs = t - HW - 1;
      float va[8], vs[8]; unpack8(raw[2 * HW - 1 + o], va); unpack8(raw[o - 1], vs);
      const bool oka = qa < SEQ, oks = qs >= 0;
#pragma unroll
      for (int k = 0; k < 8; ++k) s[k] += (oka ? va[k] : 0.f) - (oks ? vs[k] : 0.f);
    }
    const int lo = max(t - HW, 0), hi = min(t + HW, SEQ);
    const float inv = 1.0f / (float)(hi - lo);
    float hv[8]; unpack8(raw[HW + o], hv);
    float r[8];
#pragma unroll
    for (int k = 0; k < 8; ++k) r[k] = s[k] * inv - hv[k];
    u32x4 ow; ow.x = cvt_pk_bf16(r[0], r[1]); ow.y = cvt_pk_bf16(r[2], r[3]); ow.z = cvt_pk_bf16(r[4], r[5]); ow.w = cvt_pk_bf16(r[6], r[7]);
    *(u32x4*)(PM + ((size_t)gi * SEQ + t) * 512 + (c0 & 511)) = ow;
  }
}
__device__ __forceinline__ void phase_pma(KP p, int tid) {
  const bf16_t* HA = (const bf16_t*)(p->ws + WS_HA); bf16_t* PM = (bf16_t*)(p->ws + WS_PMA);
  const int total = (SEQ / 8) * 256;
#pragma unroll 1
  for (int it = blockIdx.x * NTH + tid; it < total; it += gridDim.x * NTH) {
    const int t0 = (it >> 8) << 3, c0 = (it & 255) << 3; const int gi = c0 >> 9;
    if (gi == 0) pma_run<1>(HA, PM, 0, t0, c0); else if (gi == 1) pma_run<2>(HA, PM, 1, t0, c0); else if (gi == 2) pma_run<4>(HA, PM, 2, t0, c0); else pma_run<8>(HA, PM, 3, t0, c0);
  }
}

#define XB_TMO      128
#define XB_XCNT(j)  (256  + 64 * (j))
#define XB_XSUB(j)  (1280 + 64 * (j))
#define XB_XGEN(j)  (2304 + 64 * (j))
#define XB_TOP      3328
#define XB_TOPGEN   3392
#define XCD_BAR_WORDS 3456
#define XB_SPIN_CAP (1u << 18)
__device__ __forceinline__ unsigned xb_ld(unsigned* p)              { return __hip_atomic_load(p, __ATOMIC_RELAXED, __HIP_MEMORY_SCOPE_AGENT); }
__device__ __forceinline__ unsigned xb_add(unsigned* p, unsigned v) { return __hip_atomic_fetch_add(p, v, __ATOMIC_RELAXED, __HIP_MEMORY_SCOPE_AGENT); }
__device__ __forceinline__ unsigned xb_xcc_id() { return (unsigned)__builtin_amdgcn_s_getreg((3 << 11) | 20) & 0xFu; }
#define XB_SPIN(cond, bar) do { unsigned _sp = 0; while (cond) { __builtin_amdgcn_s_sleep(1); \
    if ((++_sp & 255u) == 0u) { if (xb_ld(&(bar)[XB_TMO])) break; if (_sp > XB_SPIN_CAP) { atomicAdd(&(bar)[XB_TMO], 1u); break; } } } } while (0)
struct XcdBarrier { unsigned* bar; unsigned x; volatile LAS unsigned* st; };
__device__ __forceinline__ XcdBarrier xcd_barrier_post(unsigned* bar, volatile LAS unsigned* st, bool leader) {
  XcdBarrier b; b.bar = bar; b.x = xb_xcc_id(); b.st = st;
  if (leader) (void)xb_add(&bar[XB_XCNT(b.x)], 1u);
  return b;
}
__device__ __forceinline__ void xcd_barrier_complete(unsigned* bar, unsigned x, unsigned& nloc, unsigned& nx) {
  const unsigned G = gridDim.x * gridDim.y * gridDim.z;
  unsigned sum, cnt, mine, sp = 0u;
  for (;;) {
    sum = 0u; cnt = 0u; mine = 0u;
#pragma unroll
    for (unsigned j = 0; j < 16; ++j) { const unsigned c = xb_ld(&bar[XB_XCNT(j)]); sum += c; cnt += (c > 0u) ? 1u : 0u; mine = (j == x) ? c : mine; }
    if (sum == G) break;
    __builtin_amdgcn_s_sleep(1);
    if ((++sp & 255u) == 0u) { if (xb_ld(&bar[XB_TMO])) break; if (sp > XB_SPIN_CAP) { atomicAdd(&bar[XB_TMO], 1u); break; } }
  }
  nloc = mine > 0u ? mine : 1u; nx = cnt > 0u ? cnt : 1u;
}
__device__ __forceinline__ void xcd_barrier(const XcdBarrier& b, bool leader) {
  asm volatile("s_waitcnt vmcnt(0)" ::: "memory");
  __syncthreads();
  if (leader) {
    unsigned* bar = b.bar;
    __builtin_amdgcn_s_waitcnt(0);
    unsigned nloc = b.st[0], nx = b.st[1];
    if (nloc == 0u) { xcd_barrier_complete(bar, b.x, nloc, nx); b.st[0] = nloc; b.st[1] = nx; }
    const unsigned old = xb_add(&bar[XB_XSUB(b.x)], 1u);
    const unsigned gen = old / nloc;
    if (old + 1u == (gen + 1u) * nloc) {
      __builtin_amdgcn_fence(__ATOMIC_RELEASE, "agent");
      asm volatile("s_waitcnt vmcnt(0)" ::: "memory");
      const unsigned og = xb_add(&bar[XB_TOP], 1u);
      const unsigned tg = og / nx;
      if (og + 1u == (tg + 1u) * nx) xb_add(&bar[XB_TOPGEN], 1u);
      else XB_SPIN(xb_ld(&bar[XB_TOPGEN]) == tg, bar);
      __builtin_amdgcn_fence(__ATOMIC_ACQUIRE, "agent");
      xb_add(&bar[XB_XGEN(b.x)], 1u);
      asm volatile("s_waitcnt vmcnt(0)" ::: "memory");
    } else {
      XB_SPIN(xb_ld(&bar[XB_XGEN(b.x)]) == gen, bar);
      __builtin_amdgcn_fence(__ATOMIC_ACQUIRE, "agent");
      asm volatile("s_waitcnt vmcnt(0)" ::: "memory");
    }
  }
  __syncthreads();
}

__global__ void __launch_bounds__(512, 2) mk_fwd(Params p) {
  extern __shared__ __attribute__((aligned(16))) unsigned char shm[];
  cg::grid_group grid = cg::this_grid();
  volatile LAS unsigned* xst = (volatile LAS unsigned*)(shm + LDS_MAIN);
  const int wave_id = __builtin_amdgcn_readfirstlane((int)(threadIdx.x >> 6));
  { const int t0 = fresh_tid(wave_id); if (t0 < 4) xst[t0] = 0u; }
  __syncthreads();
  (void)xcd_barrier_post((unsigned*)(p.ws + WS_BAR), xst, fresh_tid(wave_id) == 0);
#ifdef REPEAT_PH
  int rep = 0;
#endif
#pragma unroll 1
  for (int ph = p.ph_lo; ph < p.ph_hi; ++ph) {
    int tid = fresh_tid(wave_id);
    KP kp = (KP)__builtin_amdgcn_kernarg_segment_ptr(); asm volatile("" : "+s"(kp));
    switch (ph) {
      case 0: phase_prep(kp, shm, tid); break;
      case 1: case 7: case 11: case 14: case 18: phase_norm(kp, ph, shm, tid); break;
      case 2: case 6: case 8: case 10: case 13: case 15: case 17: phase_gemm(kp, ph, shm, tid); break;
      case 3:
#ifdef REP_HY
        for (int u = blockIdx.x; u < 512; u += gridDim.x) hyena_unit<REP_HY>(kp, u, (float2*)shm, wave_id);
#endif
        for (int u = blockIdx.x; u < 512; u += gridDim.x) hyena_unit<0>(kp, u, (float2*)shm, wave_id);
#ifdef REP_HG1
#pragma unroll 1
        for (int rr = 0; rr < 2; ++rr)
#endif
        for (int u = blockIdx.x; u < 272; u += gridDim.x) { hg1_unit(kp, u, shm, tid); __syncthreads(); }
        if ((int)gridDim.x > 32) { if ((int)blockIdx.x >= 16) tr_jobs_part(kp->in[28], DM, 2 * DFF, (bf16_t*)(kp->ws + WS_WT_UP), (float*)shm, tid, (int)blockIdx.x - 16, (int)gridDim.x - 16); }
        else tr_jobs(kp->in[28], DM, 2 * DFF, (bf16_t*)(kp->ws + WS_WT_UP), (float*)shm, tid);
        break;
      case 4:
        for (int u = blockIdx.x; u < 256; u += gridDim.x) hg2_unit(kp, u, shm, tid);
        for (int u = blockIdx.x; u < 2048; u += gridDim.x) hy_headnorm_unit(kp, u, (float*)shm, tid);
        break;
      case 5: phase_hgcomb(kp, tid); break;
      case 9: case 16:
        phase_conv(kp, ph == 16, tid);
        if (ph == 9) tr_jobs(kp->in[28] + (size_t)DM * 2 * DFF, DM, 2 * DFF, (bf16_t*)(kp->ws + WS_WT_UP), (float*)shm, tid);
        break;
      case 12: phase_pma(kp, tid); break;
      default: break;
    }
    if (ph + 1 < p.ph_hi) {
      if (p.ph_hi > 1000) grid.sync();
      { XcdBarrier xb; xb.bar = (unsigned*)(kp->ws + WS_BAR); xb.x = xb_xcc_id(); xb.st = (volatile LAS unsigned*)(shm + LDS_MAIN); xcd_barrier(xb, fresh_tid(wave_id) == 0); }
    }
#ifdef REPEAT_PH
    if (ph == REPEAT_PH && rep == 0) { rep = 1; --ph; }
#endif
  }
}

extern "C" void kernel_launch(void* const* d_in, const int* in_sizes, int n_in, void* d_out, int out_size, void* d_ws, size_t ws_size, hipStream_t stream) {
  static int grid_blocks = 0;
  if (!grid_blocks) {
    int dev = 0, cus = 0, per_cu = 0;
    (void)hipGetDevice(&dev);
    (void)hipDeviceGetAttribute(&cus, hipDeviceAttributeMultiprocessorCount, dev);
    (void)hipFuncSetAttribute((const void*)mk_fwd, hipFuncAttributeMaxDynamicSharedMemorySize, LDS_BYTES);
    (void)hipOccupancyMaxActiveBlocksPerMultiprocessor(&per_cu, (const void*)mk_fwd, NTH, LDS_BYTES);
    if (per_cu < 1) per_cu = 1;
    grid_blocks = cus * per_cu;
    if (grid_blocks > 256) grid_blocks = 256;
    if (ws_size < WS_END) fprintf(stderr, "kernel_launch: workspace too small: %zu < %zu\n", ws_size, (size_t)WS_END);
  }
  Params p{};
  for (int i = 0; i < 33; ++i) p.in[i] = (const float*)d_in[i];
  p.out = (float*)d_out; p.ws = (unsigned char*)d_ws; p.ph_lo = 0; p.ph_hi = 19;
  (void)hipMemsetAsync((unsigned char*)d_ws + WS_BAR, 0, XCD_BAR_WORDS * sizeof(unsigned), stream);
  void* args[] = {&p};
  hipError_t e = hipLaunchCooperativeKernel((const void*)mk_fwd, dim3(grid_blocks), dim3(NTH), args, LDS_BYTES, stream);
  if (e != hipSuccess) fprintf(stderr, "cooperative launch failed: %s (grid %d)\n", hipGetErrorString(e), grid_blocks);
}
```
